# Optimizing an MI355X kernel written in HIP

```python
import jax, jax.numpy as jnp
from jax import lax
import numpy as np

D_MODEL = 1024
BATCH = 2
SEQ = 8192
DEPTH = 4

HEAD_DIM = 64
N_SB_HEADS = 8
N_FOX_HEADS = 8
D_SB = N_SB_HEADS * HEAD_DIM
D_FOX = N_FOX_HEADS * HEAD_DIM
D_MIX = D_SB + D_FOX
D_IN = 3 * D_SB + 3 * D_FOX + D_MIX + N_FOX_HEADS
Q_BLOCK = 128
EPS = 1e-6

kernel_name = "hybrid_stickbreaking_fox_adaln"


def rmsnorm(x, g):
    x32 = x.astype(jnp.float32)
    r = lax.rsqrt(jnp.mean(x32 * x32, axis=-1, keepdims=True) + EPS)
    return (x32 * r).astype(x.dtype) * g


def to_heads(t, n_heads):
    b, s, _ = t.shape
    return t.reshape(b, s, n_heads, HEAD_DIM).transpose(0, 2, 1, 3)


def from_heads(t):
    b, h, s, d = t.shape
    return t.transpose(0, 2, 1, 3).reshape(b, s, h * d)


def to_query_blocks(t):
    b, h, s = t.shape[:3]
    nb = s // Q_BLOCK
    t = t.reshape((b, h, nb, Q_BLOCK) + t.shape[3:])
    return jnp.moveaxis(t, 2, 0)


def from_query_blocks(t):
    nb, b, h, qb, d = t.shape
    return jnp.moveaxis(t, 0, 2).reshape(b, h, nb * qb, d)


def stick_breaking_attention(q, k, v):
    s_len = q.shape[2]
    scale = HEAD_DIM ** -0.5
    key_pos = jnp.arange(s_len)

    def block(args):
        qb, i = args
        q_pos = i * Q_BLOCK + jnp.arange(Q_BLOCK)
        z = jnp.einsum('bhqd,bhkd->bhqk', qb, k).astype(jnp.float32) * scale
        causal = key_pos[None, :] < q_pos[:, None]
        log_rem = jnp.where(causal, jax.nn.log_sigmoid(-z), 0.0)
        after = lax.cumsum(log_rem, axis=3, reverse=True) - log_rem
        a = jnp.where(causal, jnp.exp(jax.nn.log_sigmoid(z) + after), 0.0)
        return jnp.einsum('bhqk,bhkd->bhqd', a.astype(v.dtype), v)

    out = lax.map(block, (to_query_blocks(q), jnp.arange(s_len // Q_BLOCK)))
    return from_query_blocks(out)


def forgetting_attention(q, k, v, log_f):
    s_len = q.shape[2]
    scale = HEAD_DIM ** -0.5
    key_pos = jnp.arange(s_len)
    cum = lax.cumsum(log_f, axis=2)

    def block(args):
        qb, cum_q, i = args
        q_pos = i * Q_BLOCK + jnp.arange(Q_BLOCK)
        logits = jnp.einsum('bhqd,bhkd->bhqk', qb, k).astype(jnp.float32) * scale
        logits = logits + cum_q[..., :, None] - cum[..., None, :]
        causal = key_pos[None, :] <= q_pos[:, None]
        p = jax.nn.softmax(jnp.where(causal, logits, -jnp.inf), axis=-1)
        return jnp.einsum('bhqk,bhkd->bhqd', p.astype(v.dtype), v)

    out = lax.map(block, (to_query_blocks(q), to_query_blocks(cum), jnp.arange(s_len // Q_BLOCK)))
    return from_query_blocks(out)


def setup_inputs(seed: int = 0) -> dict:
    key = jax.random.key(seed)
    ks = jax.random.split(key, 12)
    x = jax.random.normal(ks[0], (BATCH, SEQ, D_MODEL), jnp.float32)
    c = jax.random.normal(ks[1], (BATCH, D_MODEL), jnp.float32)
    w_ada = jax.random.normal(ks[2], (DEPTH, D_MODEL, 3 * D_MODEL), jnp.float32) * (0.1 * D_MODEL ** -0.5)
    b_ada = jax.random.normal(ks[3], (DEPTH, 3 * D_MODEL), jnp.float32) * 0.02
    g_norm = 1.0 + 0.02 * jax.random.normal(ks[4], (DEPTH, D_MODEL), jnp.float32)
    w_in = jax.random.normal(ks[5], (DEPTH, D_MODEL, D_IN), jnp.float32) * (D_MODEL ** -0.5)
    b_f = (jnp.linspace(1.0, 6.0, N_FOX_HEADS, dtype=jnp.float32)[None, :]
           + 0.1 * jax.random.normal(ks[6], (DEPTH, N_FOX_HEADS), jnp.float32))
    g_grp = 1.0 + 0.02 * jax.random.normal(ks[7], (DEPTH, D_MIX), jnp.float32)
    w_out = jax.random.normal(ks[8], (DEPTH, D_MIX, D_MODEL), jnp.float32) * (D_MIX ** -0.5)
    g_final = 1.0 + 0.02 * jax.random.normal(ks[9], (D_MODEL,), jnp.float32)
    return {"x": x, "c": c, "w_ada": w_ada, "b_ada": b_ada, "g_norm": g_norm,
            "w_in": w_in, "b_f": b_f, "g_grp": g_grp, "w_out": w_out, "g_final": g_final}


def reference(x, c, w_ada, b_ada, g_norm, w_in, b_f, g_grp, w_out, g_final):
    split_points = list(np.cumsum([D_SB, D_SB, D_SB, D_FOX, D_FOX, D_FOX, D_MIX]))
    c_act = jax.nn.silu(c)
    for layer in range(DEPTH):
        ada = c_act @ w_ada[layer] + b_ada[layer]
        shift, scale, gate = jnp.split(ada, 3, axis=-1)
        h = rmsnorm(x, g_norm[layer]) * (1.0 + scale[:, None, :]) + shift[:, None, :]

        z = h @ w_in[layer]
        q_sb, k_sb, v_sb, q_fx, k_fx, v_fx, g_path, f_logit = jnp.split(z, split_points, axis=-1)

        o_sb = from_heads(stick_breaking_attention(
            to_heads(q_sb, N_SB_HEADS), to_heads(k_sb, N_SB_HEADS), to_heads(v_sb, N_SB_HEADS)))

        log_f = jax.nn.log_sigmoid((f_logit + b_f[layer]).astype(jnp.float32)).transpose(0, 2, 1)
        o_fx = from_heads(forgetting_attention(
            to_heads(q_fx, N_FOX_HEADS), to_heads(k_fx, N_FOX_HEADS), to_heads(v_fx, N_FOX_HEADS), log_f))

        y = jnp.concatenate([rmsnorm(o_sb, g_grp[layer, :D_SB]),
                             rmsnorm(o_fx, g_grp[layer, D_SB:])], axis=-1)
        y = y * jax.nn.silu(g_path)
        x = x + (1.0 + gate[:, None, :]) * (y @ w_out[layer])
    return rmsnorm(x, g_final)
```

```cpp
#include <hip/hip_runtime.h>
#include <hip/hip_cooperative_groups.h>
#include <cstdio>
#include <cstdint>
namespace cg = cooperative_groups;
namespace pg8 {
#define PG8_LAS __attribute__((address_space(3)))
typedef unsigned short bf16_t;
typedef short bf16x8 __attribute__((ext_vector_type(8)));
typedef float f32x4 __attribute__((ext_vector_type(4)));
typedef unsigned u32x4 __attribute__((ext_vector_type(4)));
constexpr int BM = 256, BK = 64, HALF = 128, HTB = HALF * BK * 2  , STAGE_BYTES = 8 * HTB, NXCD = 8, WGM = 8;

__host__ __device__ __forceinline__ int lds_byte(int r, int c) { const int st = (r >> 4) * 2 + (c >> 5), rr = r & 15, cc = c & 31, ob = rr * 64 + cc * 2; return st * 1024 + (ob ^ (((ob >> 9) & 1) << 5)); }
__host__ __device__ __forceinline__ void stage_rc(int b, int& R, int& C) { const int st = b / 1024, sb = b % 1024, swz = sb ^ (((sb >> 9) & 1) << 5); R = (st >> 1) * 16 + swz / 64; C = (st & 1) * 32 + (swz % 64) / 2; }
__host__ __device__ __forceinline__ int perm32(int rho) { const int n = rho >> 4, i = rho & 15; return 8 * (i >> 2) + 4 * n + (i & 3); }

struct Unit { int pm, pn; };
struct Gemm { const bf16_t* A; const bf16_t* Bt; int M, N, K; };

struct StaticOrder {
    int nM, nN, nwg, G, c;
    __host__ __device__ void init(int M, int N, int G_, int c_) { nM = M / BM; nN = N / BM; nwg = nM * nN; G = G_; c = c_; }
    __host__ __device__ bool next(int i, Unit& u) const {
        const long L = (long)i * G + c; if (L >= nwg) return false;
        int wgid = (int)L; { const int q = nwg / NXCD, r = nwg % NXCD, xcd = wgid % NXCD, off = wgid / NXCD; wgid = (xcd < r ? xcd * (q + 1) : r * (q + 1) + (xcd - r) * q) + off; }
        const int nig = WGM * nN, gid = wgid / nig, fm = gid * WGM, gsz = (nM - fm) < WGM ? (nM - fm) : WGM;
        u.pm = fm + ((wgid % nig) % gsz); u.pn = (wgid % nig) / gsz; return true;
    }
    __device__ __forceinline__ void a_ready(const Unit&) const {}
    __device__ __forceinline__ void done(const Unit&) const {}
};

__device__ __forceinline__ unsigned cvt_pk_bf16(float lo, float hi) { unsigned r; asm volatile("v_cvt_pk_bf16_f32 %0, %1, %2" : "=v"(r) : "v"(lo), "v"(hi)); return r; }
typedef float f32x2 __attribute__((ext_vector_type(2)));
__device__ __forceinline__ f32x2 gelu_pk(f32x2 v) {
    const f32x2 av = __builtin_elementwise_abs(v), d = av * 0.2316418882f + 1.0f;
    f32x2 t; t.x = __builtin_amdgcn_rcpf(d.x); t.y = __builtin_amdgcn_rcpf(d.y);
    f32x2 q = t * 0.5307027145f + (-0.7265760135f); q = q * t + 0.7107068705f; q = q * t + (-0.142248368f); q = q * t + 0.127414796f; q = q * t;
    const f32x2 s = (v * v) * (-0.72134752044f);
    f32x2 e; e.x = __builtin_amdgcn_exp2f(s.x); e.y = __builtin_amdgcn_exp2f(s.y);
    const f32x2 m = v * (q * e), r = v - m;
    f32x2 o; o.x = v.x < 0.f ? m.x : r.x; o.y = v.y < 0.f ? m.y : r.y; return o;
}

template <int ACT  > struct EpiBf16 {
    static constexpr bool PERM = true, AFTER_DRAIN = false, MID = false; static_assert(ACT == 0 || ACT == 1, "EpiBf16: ACT is 0 (none) or 1 (gelu_pk)");
    bf16_t* vt; int vt_tile, vt_cols;
    unsigned* kn; int kn_tile, kn_col0, kn_rows;
    bf16_t* O; int ldc; const float* bias; int split_cols; size_t split_stride; float scale0;
    __device__ __forceinline__ void operator()(const f32x4 (&acc)[2][2][4][2], const Unit& u, int wr, int wc, int fr, int fq) const {
        const int row0 = u.pm * BM + wr * 64 + fr; int colt = u.pn * BM; bf16_t* base = O;
        float sc = 1.f; int tsp = 0; if (split_cols) { const int t = colt / split_cols; tsp = t; base += (size_t)t * split_stride; colt -= t * split_cols; if (t == 0) sc = scale0; }
        if (kn && tsp == kn_tile && colt >= kn_col0) {
#pragma unroll
            for (int ai = 0; ai < 2; ++ai)
#pragma unroll
                for (int bj = 0; bj < 2; ++bj) { float mx = 0.f;
#pragma unroll
                    for (int m = 0; m < 4; ++m) { const f32x4 a = acc[ai][bj][m][0], b = acc[ai][bj][m][1]; float s = (a[0] * a[0] + a[1] * a[1]) + (a[2] * a[2] + a[3] * a[3]) + (b[0] * b[0] + b[1] * b[1]) + (b[2] * b[2] + b[3] * b[3]);
                        s += __shfl_xor(s, 16); s += __shfl_xor(s, 32); mx = __builtin_fmaxf(mx, s); }
                    mx = __builtin_fmaxf(mx, __shfl_xor(mx, 1)); mx = __builtin_fmaxf(mx, __shfl_xor(mx, 2)); mx = __builtin_fmaxf(mx, __shfl_xor(mx, 4)); mx = __builtin_fmaxf(mx, __shfl_xor(mx, 8));
                    if (fr == 0 && fq == 0) { const int r0 = u.pm * BM + ai * HALF + wr * 64, bb = r0 / kn_rows, tile = (r0 % kn_rows) >> 6, h8 = (colt - kn_col0 + bj * HALF + wc * 32) >> 6;
                        atomicMax(kn + ((size_t)(bb * 8 + h8) * 128 + tile) * 2 + (wc & 1), __float_as_uint(mx)); } }
        }
        const int col0 = colt + wc * 32 + 8 * fq, bcol0 = u.pn * BM + wc * 32 + 8 * fq;
        f32x4 bv[2][2];
#pragma unroll
        for (int bj = 0; bj < 2; ++bj)
#pragma unroll
            for (int n = 0; n < 2; ++n) bv[bj][n] = bias ? *(const f32x4*)(bias + bcol0 + bj * HALF + 4 * n) : (f32x4){0.f, 0.f, 0.f, 0.f};
#pragma unroll
        for (int ai = 0; ai < 2; ++ai)
#pragma unroll
            for (int m = 0; m < 4; ++m) { bf16_t* rowp = base + (size_t)(row0 + ai * HALF + m * 16) * ldc + col0;
#pragma unroll
                for (int bj = 0; bj < 2; ++bj) { f32x4 v0 = acc[ai][bj][m][0] + bv[bj][0], v1 = acc[ai][bj][m][1] + bv[bj][1];
                    if (ACT == 1) { f32x2 a = gelu_pk((f32x2){v0[0], v0[1]}), b = gelu_pk((f32x2){v0[2], v0[3]}), c = gelu_pk((f32x2){v1[0], v1[1]}), d = gelu_pk((f32x2){v1[2], v1[3]});
                        v0 = (f32x4){a.x, a.y, b.x, b.y}; v1 = (f32x4){c.x, c.y, d.x, d.y}; }
                    v0 = v0 * sc; v1 = v1 * sc; u32x4 w; w.x = cvt_pk_bf16(v0[0], v0[1]); w.y = cvt_pk_bf16(v0[2], v0[3]); w.z = cvt_pk_bf16(v1[0], v1[1]); w.w = cvt_pk_bf16(v1[2], v1[3]);
                    *(u32x4*)(rowp + bj * HALF) = w;
                    if (vt && tsp == vt_tile && colt < vt_cols) { const int row = row0 + ai * HALF + m * 16, c0 = col0 + bj * HALF; bf16_t* tp = vt + ((size_t)((row / kn_rows) * 8 + (c0 >> 6)) * 64 + (c0 & 63)) * kn_rows + (row % kn_rows);
#pragma unroll
                        for (int j = 0; j < 4; ++j) { tp[(size_t)(2 * j) * kn_rows] = (bf16_t)(w[j] & 0xffffu); tp[(size_t)(2 * j + 1) * kn_rows] = (bf16_t)(w[j] >> 16); } } } }
    }
};
struct EpiRes {
    static constexpr bool PERM = false, AFTER_DRAIN = false, MID = true;
    const float* base; float* out; int ldc; const float* gate; int rows_per_batch; int ldg; const float* ssq; float eps;
    __device__ __forceinline__ void group_ms(int row, float& m0, float& m1) const {
        const f32x4* p = (const f32x4*)(ssq + (size_t)row * 16); const f32x4 a = p[0], b = p[1], c = p[2], d = p[3];
        m0 = (((a[0] + a[1]) + (a[2] + a[3])) + ((b[0] + b[1]) + (b[2] + b[3]))) * (1.f / 512.f) + eps;
        m1 = (((c[0] + c[1]) + (c[2] + c[3])) + ((d[0] + d[1]) + (d[2] + d[3]))) * (1.f / 512.f) + eps; }
    __device__ __forceinline__ void mid(f32x4 (&acc)[2][2][4][2], const Unit& u, int wr, int fr) const {
#pragma unroll
        for (int ai = 0; ai < 2; ++ai)
#pragma unroll
            for (int m = 0; m < 4; ++m) { float m0, m1; group_ms(u.pm * BM + ai * HALF + wr * 64 + m * 16 + fr, m0, m1); const float ratio = sqrtf(m1 / m0);
#pragma unroll
                for (int bj = 0; bj < 2; ++bj)
#pragma unroll
                    for (int n = 0; n < 2; ++n) acc[ai][bj][m][n] = acc[ai][bj][m][n] * ratio; }
    }
    __device__ __forceinline__ void operator()(const f32x4 (&acc)[2][2][4][2], const Unit& u, int wr, int wc, int fr, int fq) const {
        const int col0 = u.pn * BM + wc * 32 + 4 * fq;
        const float* gp = gate + (size_t)((u.pm * BM) / rows_per_batch) * ldg + col0;
        f32x4 gv[2][2];
#pragma unroll
        for (int bj = 0; bj < 2; ++bj)
#pragma unroll
            for (int n = 0; n < 2; ++n) gv[bj][n] = *(const f32x4*)(gp + bj * HALF + n * 16) + 1.0f;
#pragma unroll
        for (int ai = 0; ai < 2; ++ai)
#pragma unroll
            for (int m = 0; m < 4; ++m) { const int row = u.pm * BM + ai * HALF + wr * 64 + m * 16 + fr; const size_t off = (size_t)row * ldc + col0;
                float m0, m1; group_ms(row, m0, m1); const float rfx = 1.0f / sqrtf(m1);
#pragma unroll
                for (int bj = 0; bj < 2; ++bj)
#pragma unroll
                    for (int n = 0; n < 2; ++n) { const f32x4 bs = *(const f32x4*)(base + off + bj * HALF + n * 16);
                        *(f32x4*)(out + off + bj * HALF + n * 16) = bs + gv[bj][n] * (acc[ai][bj][m][n] * rfx); }
                if (m & 1) asm volatile("" ::: "memory"); }
    }
};

template <class Epi, class Sched, bool ALIGN_EPI = false, bool SP2 = false>
__device__ __forceinline__ void gemm_phase(PG8_LAS unsigned char* lds, const Gemm g, const Sched& S, const Epi& E) {
    int tid_o = threadIdx.x; asm volatile("" : "+v"(tid_o));
    const int tid = tid_o, wid = __builtin_amdgcn_readfirstlane(tid >> 6), lane = tid & 63, wr = wid >> 2, wc = wid & 3, fr = lane & 15, fq = lane >> 4;
    const int K = g.K, nt = K / BK;
    unsigned voffA[2], voffB[2];
#pragma unroll
    for (int i = 0; i < 2; ++i) { int R, C; stage_rc(tid * 16 + i * 8192, R, C); const int Rb = Epi::PERM ? ((R & ~31) + perm32(R & 31)) : R;
        voffA[i] = (unsigned)(R * K + C) * 2u; voffB[i] = (unsigned)(Rb * K + C) * 2u; }
    const size_t kstep = (size_t)(BK * 2);
    const size_t hstep = (size_t)HALF * K * 2;
    const size_t tstep = 2 * hstep;
    const unsigned ldsw = (unsigned)wid * 1024u;
    const int aoff = lds_byte(wr * 64 + fr, fq * 8), boff = lds_byte(wc * 32 + fr, fq * 8);
#define PG8_SA(b, h) (((b) * 2 + (h)) * HTB)
#define PG8_SB(b, h) ((4 + (b) * 2 + (h)) * HTB)
#define PG8_STAGE(bufoff, gbase, voff) do { _Pragma("unroll") for (int _i = 0; _i < 2; ++_i) \
        __builtin_amdgcn_global_load_lds((const unsigned*)((const char*)(gbase) + (voff)[_i]), (PG8_LAS unsigned*)(lds + (bufoff) + ldsw + _i * 8192), 16, 0, 0); } while (0)
#define PG8_LDA(dst, b, h) do { _Pragma("unroll") for (int m = 0; m < 4; ++m) _Pragma("unroll") for (int k = 0; k < 2; ++k) dst[m][k] = *(const PG8_LAS bf16x8*)(lds + PG8_SA(b, h) + aoff + m * 2048 + k * 1024); } while (0)
#define PG8_LDB(dst, b, h) do { _Pragma("unroll") for (int n = 0; n < 2; ++n) _Pragma("unroll") for (int k = 0; k < 2; ++k) dst[n][k] = *(const PG8_LAS bf16x8*)(lds + PG8_SB(b, h) + boff + n * 2048 + k * 1024); } while (0)
#define PG8_MMA(ai, bj, At, Bt) do { __builtin_amdgcn_s_setprio(1); _Pragma("unroll") for (int m = 0; m < 4; ++m) _Pragma("unroll") for (int n = 0; n < 2; ++n) _Pragma("unroll") for (int k = 0; k < 2; ++k) \
        acc[ai][bj][m][n] = __builtin_amdgcn_mfma_f32_16x16x32_bf16(Bt[n][k], At[m][k], acc[ai][bj][m][n], 0, 0, 0); __builtin_amdgcn_s_setprio(0); } while (0)
#define PG8_WAIT_V(n) asm volatile("s_waitcnt vmcnt(" #n ")" ::: "memory")
#define PG8_WAIT_L(n) asm volatile("s_waitcnt lgkmcnt(" #n ")" ::: "memory")
#define PG8_BAR __builtin_amdgcn_s_barrier()
#define PG8_SCHED __builtin_amdgcn_sched_barrier(0)
    Unit cur, nxt; int ui = 0;
    if (!S.next(0, cur)) return;
    f32x4 acc[2][2][4][2];
#pragma unroll
    for (int a = 0; a < 2; ++a)
#pragma unroll
        for (int b = 0; b < 2; ++b)
#pragma unroll
            for (int m = 0; m < 4; ++m)
#pragma unroll
                for (int n = 0; n < 2; ++n) acc[a][b][m][n] = (f32x4){0.f, 0.f, 0.f, 0.f};
    bf16x8 At[4][2], B0[2][2], B1[2][2];
    const char* cA = (const char*)g.A + (size_t)cur.pm * tstep; const char* cB = (const char*)g.Bt + (size_t)cur.pn * tstep;
    S.a_ready(cur);
    if constexpr (SP2) {
        PG8_STAGE(PG8_SB(0, 0), cB, voffB); PG8_STAGE(PG8_SB(0, 1), cB + hstep, voffB); PG8_STAGE(PG8_SA(0, 0), cA, voffA); PG8_STAGE(PG8_SA(0, 1), cA + hstep, voffA);
        if (wr == 1) PG8_BAR;
        PG8_WAIT_V(2); PG8_BAR;
        PG8_STAGE(PG8_SB(1, 0), cB + kstep, voffB); PG8_STAGE(PG8_SA(1, 0), cA + kstep, voffA); PG8_STAGE(PG8_SB(1, 1), cB + hstep + kstep, voffB);
        PG8_WAIT_V(6); PG8_BAR;
    } else {
        PG8_STAGE(PG8_SB(0, 0), cB, voffB); PG8_STAGE(PG8_SA(0, 0), cA, voffA); PG8_STAGE(PG8_SB(0, 1), cB + hstep, voffB); PG8_STAGE(PG8_SA(0, 1), cA + hstep, voffA);
        if (wr == 1) PG8_BAR;
        PG8_WAIT_V(4); PG8_BAR;
        PG8_STAGE(PG8_SB(1, 0), cB + kstep, voffB); PG8_STAGE(PG8_SA(1, 0), cA + kstep, voffA); PG8_STAGE(PG8_SB(1, 1), cB + hstep + kstep, voffB);
        PG8_WAIT_V(6); PG8_BAR;
    }
    for (;;) {
        const bool has_next = S.next(ui + 1, nxt);
        const char* nA = has_next ? (const char*)g.A + (size_t)nxt.pm * tstep : cA; const char* nB = has_next ? (const char*)g.Bt + (size_t)nxt.pn * tstep : cB;
        for (int t = 0; t < nt; t += 2) {
            if constexpr (Epi::MID) { if (t == nt / 2) E.mid(acc, cur, wr, fr); }
            const bool last = (t == nt - 2);
            const char* a1 = cA + (size_t)(t + 1) * kstep;
            const char* a2 = last ? nA : cA + (size_t)(t + 2) * kstep; const char* b2 = last ? nB : cB + (size_t)(t + 2) * kstep;
            const char* a3 = a2 + kstep; const char* b3 = b2 + kstep;
            if (last && has_next) S.a_ready(nxt);
            if constexpr (SP2) {
            PG8_LDB(B0, 0, 0); PG8_LDB(B1, 0, 1); PG8_SCHED; PG8_LDA(At, 0, 0); PG8_STAGE(PG8_SA(1, 1), a1 + hstep, voffA);
            PG8_WAIT_V(8); PG8_WAIT_L(0); PG8_BAR; PG8_MMA(0, 0, At, B0); PG8_MMA(0, 1, At, B1); PG8_BAR; PG8_SCHED;
            PG8_LDA(At, 0, 1); PG8_STAGE(PG8_SB(0, 0), b2, voffB); PG8_STAGE(PG8_SB(0, 1), b2 + hstep, voffB); PG8_STAGE(PG8_SA(0, 0), a2, voffA);
            PG8_WAIT_V(8); PG8_WAIT_L(0); PG8_BAR; PG8_MMA(1, 0, At, B0); PG8_MMA(1, 1, At, B1); PG8_BAR; PG8_SCHED;
            PG8_LDB(B0, 1, 0); PG8_LDB(B1, 1, 1); PG8_SCHED; PG8_LDA(At, 1, 0); PG8_STAGE(PG8_SA(0, 1), a2 + hstep, voffA);
            PG8_WAIT_V(8); PG8_WAIT_L(0); PG8_BAR; PG8_MMA(0, 0, At, B0); PG8_MMA(0, 1, At, B1); PG8_BAR; PG8_SCHED;
            PG8_LDA(At, 1, 1); PG8_STAGE(PG8_SB(1, 0), b3, voffB); PG8_STAGE(PG8_SB(1, 1), b3 + hstep, voffB); PG8_STAGE(PG8_SA(1, 0), a3, voffA);
            PG8_WAIT_V(8); PG8_WAIT_L(0); PG8_BAR; PG8_MMA(1, 0, At, B0); PG8_MMA(1, 1, At, B1); PG8_BAR; PG8_SCHED;
            } else {
            PG8_LDB(B0, 0, 0); PG8_SCHED; PG8_LDA(At, 0, 0); PG8_STAGE(PG8_SA(1, 1), a1 + hstep, voffA);
            PG8_WAIT_L(8); PG8_BAR; PG8_WAIT_L(0); PG8_MMA(0, 0, At, B0); PG8_BAR; PG8_SCHED;
            PG8_LDB(B1, 0, 1); PG8_STAGE(PG8_SB(0, 0), b2, voffB);
            PG8_BAR; PG8_WAIT_L(0); PG8_MMA(0, 1, At, B1); PG8_BAR;
            PG8_LDA(At, 0, 1); PG8_STAGE(PG8_SA(0, 0), a2, voffA);
            PG8_BAR; PG8_WAIT_L(0); PG8_MMA(1, 0, At, B0); PG8_BAR; PG8_SCHED;
            PG8_STAGE(PG8_SB(0, 1), b2 + hstep, voffB);
            PG8_WAIT_V(6); PG8_BAR; PG8_MMA(1, 1, At, B1); PG8_BAR;
            PG8_LDB(B0, 1, 0); PG8_SCHED; PG8_LDA(At, 1, 0); PG8_STAGE(PG8_SA(0, 1), a2 + hstep, voffA);
            PG8_WAIT_L(8); PG8_BAR; PG8_WAIT_L(0); PG8_MMA(0, 0, At, B0); PG8_BAR; PG8_SCHED;
            PG8_LDB(B1, 1, 1); PG8_STAGE(PG8_SB(1, 0), b3, voffB);
            PG8_BAR; PG8_WAIT_L(0); PG8_MMA(0, 1, At, B1); PG8_BAR;
            PG8_LDA(At, 1, 1); PG8_STAGE(PG8_SA(1, 0), a3, voffA);
            PG8_BAR; PG8_WAIT_L(0); PG8_MMA(1, 0, At, B0); PG8_BAR; PG8_SCHED;
            PG8_STAGE(PG8_SB(1, 1), b3 + hstep, voffB);
            PG8_WAIT_V(6); PG8_BAR; PG8_MMA(1, 1, At, B1); PG8_BAR;
            }
        }
        if constexpr (ALIGN_EPI) { if (wr == 0) PG8_BAR; }
        if constexpr (!Epi::AFTER_DRAIN) { E(acc, cur, wr, wc, fr, fq); S.done(cur); }
        if (!has_next) break;
#pragma unroll
        for (int a = 0; a < 2; ++a)
#pragma unroll
            for (int b = 0; b < 2; ++b)
#pragma unroll
                for (int m = 0; m < 4; ++m)
#pragma unroll
                    for (int n = 0; n < 2; ++n) acc[a][b][m][n] = (f32x4){0.f, 0.f, 0.f, 0.f};
        cur = nxt; cA = nA; cB = nB; ++ui;
        if constexpr (ALIGN_EPI) { if (wr == 1) PG8_BAR; }
    }
    PG8_WAIT_V(0);
    if constexpr (!ALIGN_EPI) { if (wr == 0) PG8_BAR; }
    PG8_BAR;
    if constexpr (Epi::AFTER_DRAIN) { E.fused(acc, cur, wr, wc, fr, fq, lds, wid, lane); S.done(cur); }
#undef PG8_SA
#undef PG8_SB
#undef PG8_STAGE
#undef PG8_LDA
#undef PG8_LDB
#undef PG8_MMA
#undef PG8_WAIT_V
#undef PG8_WAIT_L
#undef PG8_BAR
#undef PG8_SCHED
}
}

#ifndef PG8_SP2
#define PG8_SP2 true
#endif
#ifndef PG8_ALIGN
#define PG8_ALIGN true
#endif
#include <hip/hip_bf16.h>
#include <cmath>
namespace attn_body {
using bf16=__hip_bfloat16;
using bf16x8=__attribute__((ext_vector_type(8)))short;
using s16x4=__attribute__((ext_vector_type(4)))short;
using f32x16=__attribute__((ext_vector_type(16)))float;
using u32x4=__attribute__((ext_vector_type(4)))unsigned;
using f32x4v=__attribute__((ext_vector_type(4)))float;
constexpr int BATCH=2,NHEAD=16,SEQ=8192,D=64,DM=NHEAD*D;
constexpr int NW=8,QBLK=32,QB=QBLK*NW,KVBLK=64,NQB=SEQ/QB;
constexpr int ATTN_PITCH=DM, ATTN_UNIT_ROWS=QB;
__device__ __forceinline__ int crow(int r,int hi){return (r&3)+8*(r>>2)+4*hi;}
#define SBAR() __builtin_amdgcn_sched_barrier(0)
__device__ __forceinline__ void cmask(f32x16&p0,f32x16&p1,int jb,int qrel,int hi){
  const float NEG=-INFINITY; int kb=64*jb+4*hi;
  #pragma unroll
  for(int r=0;r<16;++r){int kv=kb+(r&3)+8*(r>>2); if(kv>qrel)p0[r]=NEG; if(kv+32>qrel)p1[r]=NEG;}
}

constexpr int NSLOT=3, SLOTB=8192;
constexpr int LDS_K=0, LDS_V=NSLOT*SLOTB, LDS_WS=2*NSLOT*SLOTB, LDS_OST=LDS_WS+NW*64*4, LDS_BIAS=LDS_OST+NW*4096, LDS_BYTES=LDS_BIAS+SEQ*4+256+1024;
constexpr float C2=0.125f*1.4426950408889634f;
__device__ __forceinline__ void glds16(const void*gsrc,unsigned lds_dst){unsigned keep;
  asm volatile("s_mov_b32 %0, m0\n\ts_mov_b32 m0, %2\n\ts_nop 0\n\tglobal_load_lds_dwordx4 %1, off\n\ts_mov_b32 m0, %0":"=&s"(keep):"v"(gsrc),"s"(lds_dst):"memory");}
__device__ __forceinline__ float max3f(float a,float b,float c){float r;asm("v_max3_f32 %0, %1, %2, %3":"=v"(r):"v"(a),"v"(b),"v"(c));return r;}
__device__ __forceinline__ float max2f(float a,float b){float r;asm("v_max_f32_e32 %0, %1, %2":"=v"(r):"v"(a),"v"(b));return r;}
__device__ __forceinline__ float fadd_s(float a,float b){float r;asm("v_add_f32_e32 %0, %1, %2":"=v"(r):"v"(a),"v"(b));return r;}
__device__ __forceinline__ float fsub_s(float a,float b){float r;asm("v_sub_f32_e32 %0, %1, %2":"=v"(r):"v"(a),"v"(b));return r;}
typedef float f32x2_t __attribute__((ext_vector_type(2))); typedef __bf16 bf16x2_t __attribute__((ext_vector_type(2)));
__device__ __forceinline__ unsigned cvtpk_s(float lo,float hi){f32x2_t v={lo,hi};bf16x2_t b=__builtin_convertvector(v,bf16x2_t);return __builtin_bit_cast(unsigned,b);}
#define WAIT_BAR(N) asm volatile("s_waitcnt vmcnt(" #N ") lgkmcnt(0)\n\ts_barrier":::"memory")
__device__ __forceinline__ float silu2(float x){ return x*__builtin_amdgcn_rcpf(1.0f+__builtin_amdgcn_exp2f(-1.4426950408889634f*x)); }

__device__ __forceinline__ void qkt(f32x16&p0,f32x16&p1,const char*Kslot,const bf16x8*qr,int r32,int hi){
  const char*kb=Kslot+hi*1024+r32*16;
  #pragma unroll
  for(int d0=0;d0<4;++d0){
    const bf16x8 b0=*reinterpret_cast<const bf16x8*>(kb+d0*2048);
    const bf16x8 b1=*reinterpret_cast<const bf16x8*>(kb+d0*2048+512);
    {p0=__builtin_amdgcn_mfma_f32_32x32x16_bf16(b0,qr[d0],p0,0,0,0);p1=__builtin_amdgcn_mfma_f32_32x32x16_bf16(b1,qr[d0],p1,0,0,0);}}
}
typedef __attribute__((address_space(3))) const char* lds_cptr;
typedef short v4i16_t __attribute__((ext_vector_type(4)));
__device__ __forceinline__ void kload8(bf16x8*kf,lds_cptr kp){
  kf[0]=*(const __attribute__((address_space(3))) bf16x8*)(kp);      kf[1]=*(const __attribute__((address_space(3))) bf16x8*)(kp+512);
  kf[2]=*(const __attribute__((address_space(3))) bf16x8*)(kp+2048); kf[3]=*(const __attribute__((address_space(3))) bf16x8*)(kp+2560);
  kf[4]=*(const __attribute__((address_space(3))) bf16x8*)(kp+4096); kf[5]=*(const __attribute__((address_space(3))) bf16x8*)(kp+4608);
  kf[6]=*(const __attribute__((address_space(3))) bf16x8*)(kp+6144); kf[7]=*(const __attribute__((address_space(3))) bf16x8*)(kp+6656);
}
__device__ __forceinline__ void kload2(bf16x8*kf,lds_cptr kp,int j){ kf[2*j]=*(const __attribute__((address_space(3))) bf16x8*)(kp+j*2048); kf[2*j+1]=*(const __attribute__((address_space(3))) bf16x8*)(kp+j*2048+512); }
__device__ __forceinline__ s16x4 vtr(lds_cptr p){ return __builtin_bit_cast(s16x4,__builtin_amdgcn_ds_read_tr16_b64_v4i16((__attribute__((address_space(3))) v4i16_t*)p)); }
__device__ __forceinline__ float rowmax(const f32x16&p0,const f32x16&p1){
  float a=max3f(p0[0],p0[1],p1[0]),b=max3f(p0[2],p0[3],p1[1]);a=max3f(a,p1[2],p1[3]);
  #pragma unroll
  for(int r=4;r<16;r+=4){a=max3f(a,p0[r],p0[r+1]);b=max3f(b,p0[r+2],p0[r+3]);a=max3f(a,p1[r],p1[r+1]);b=max3f(b,p1[r+2],p1[r+3]);}
  const float m=max2f(a,b);
  auto rr=__builtin_amdgcn_permlane32_swap(__float_as_uint(m),__float_as_uint(m),false,false);
  return max2f(__uint_as_float(rr[0]),__uint_as_float(rr[1]));
}
__device__ __forceinline__ void pv(f32x16*o,int vb,bf16x8 pa0,bf16x8 pa1,bf16x8 pa2,bf16x8 pa3){
  #pragma unroll
  for(int d0=0;d0<2;++d0){s16x4 lo[4],hi[4];
    #pragma unroll
    for(int ks=0;ks<4;++ks){
      asm volatile("ds_read_b64_tr_b16 %0,%1 offset:%c2":"=&v"(lo[ks]):"v"(vb),"i"(d0*4096+ks*1024):"memory");
      asm volatile("ds_read_b64_tr_b16 %0,%1 offset:%c2":"=&v"(hi[ks]):"v"(vb),"i"(d0*4096+ks*1024+512):"memory");}
    asm volatile("s_waitcnt lgkmcnt(0)":::"memory");SBAR();
    #define PK(k) (bf16x8){lo[k][0],lo[k][1],lo[k][2],lo[k][3],hi[k][0],hi[k][1],hi[k][2],hi[k][3]}
    o[d0]=__builtin_amdgcn_mfma_f32_32x32x16_bf16(pa0,PK(0),o[d0],0,0,0);
    o[d0]=__builtin_amdgcn_mfma_f32_32x32x16_bf16(pa1,PK(1),o[d0],0,0,0);
    o[d0]=__builtin_amdgcn_mfma_f32_32x32x16_bf16(pa2,PK(2),o[d0],0,0,0);
    o[d0]=__builtin_amdgcn_mfma_f32_32x32x16_bf16(pa3,PK(3),o[d0],0,0,0);
    #undef PK
  }
}

#ifndef ATTN_STORE16
#define ATTN_STORE16(p,v) (*(u32x4*)(p)=(v))
#endif
template<int THRL> __device__ __forceinline__ void attn_unit(int b,int h,int qb,const bf16*Q,const bf16*__restrict__ K,const bf16*__restrict__ V,bf16*O,const float*__restrict__ cum,const unsigned*__restrict__ kn,const bf16*__restrict__ Gp,const float*__restrict__ ggrp,float*__restrict__ ssq,char*shm){
  int tid_o=threadIdx.x; asm volatile("":"+v"(tid_o)); const int tid=tid_o,lane=tid&63,r32=lane&31,hi=lane>>5; const int wid=__builtin_amdgcn_readfirstlane(tid>>6);
  const long rowbase=(long)b*SEQ; const int q0=qb*QB;
  const bf16*Qw=Q+(rowbase+q0+wid*QBLK)*DM+h*D;
  const unsigned lds0=(unsigned)(uintptr_t)shm;
  float*wsf=(float*)(shm+LDS_WS)+wid*64;
  int NT=(q0+QB)/KVBLK;
  typedef __attribute__((address_space(3))) float lds_f; typedef __attribute__((address_space(3))) f32x4v lds_f4;
  lds_f* const blp=(lds_f*)((__attribute__((address_space(3))) char*)shm+LDS_BIAS);
  lds_f* const knl=blp+SEQ+64;
  { int z_=0; asm volatile("":"+v"(z_)); const float cref=cum[q0+z_]; const int n4=(q0+QB)>>2;
    for(int i=tid;i<n4;i+=NW*64){ f32x4v v=*reinterpret_cast<const f32x4v*>(cum+4*i); v=cref-v; *(lds_f4*)(blp+4*i)=v; }
    if(tid<NT) knl[tid]=__builtin_sqrtf(__uint_as_float(kn[2*tid])+__uint_as_float(kn[2*tid+1])); }
  bf16x8 qr[4];
  #pragma unroll
  for(int d0=0;d0<4;++d0)qr[d0]=*reinterpret_cast<const bf16x8*>(&Qw[(long)r32*DM+d0*16+hi*8]);
  { float qs=0.f;
    #pragma unroll
    for(int d0=0;d0<4;++d0)
      #pragma unroll
      for(int j=0;j<8;++j){ const float v=__uint_as_float(((unsigned)(unsigned short)qr[d0][j])<<16); qs+=v*v; }
    { auto rr=__builtin_amdgcn_permlane32_swap(__float_as_uint(qs),__float_as_uint(qs),false,false); qs=__uint_as_float(rr[0])+__uint_as_float(rr[1]); }
    #pragma unroll
    for(int o_=1;o_<32;o_<<=1) qs=__builtin_fmaxf(qs,__shfl_xor(qs,o_));
    if(lane==0) knl[128+wid]=qs; }
  asm volatile("s_waitcnt vmcnt(0) lgkmcnt(0)\n\ts_barrier":::"memory");
  int t_start;
  { float q2=knl[128];
    #pragma unroll
    for(int w_=1;w_<NW;++w_) q2=__builtin_fmaxf(q2,knl[128+w_]);
    const float qm=1.03f*__builtin_sqrtf(q2);
    const float ksel=__builtin_fmaxf(__builtin_fmaxf(knl[NT-4],knl[NT-3]),__builtin_fmaxf(knl[NT-2],knl[NT-1]));
    const int t0_=lane,t1_=lane+64;
    const bool ok0=(t0_<NT-4)&&(blp[64*t0_+63]+qm*(knl[t0_]+ksel)<=-152.f);
    const bool ok1=(t1_<NT-4)&&(blp[64*t1_+63]+qm*(knl[t1_]+ksel)<=-152.f);
    const unsigned long long m0=~__ballot(ok0),m1=~__ballot(ok1);
    const int f0=m0?__builtin_ctzll(m0):64,f1=m1?__builtin_ctzll(m1):64;
    t_start=(f0<64)?f0:64+f1; t_start=(t_start>NT-4)?NT-4:t_start; t_start&=~1; t_start=__builtin_amdgcn_readfirstlane(t_start); }
  NT-=t_start;
  const bf16*Kh=K+(rowbase+(long)t_start*KVBLK)*DM+h*D,*Vh=V+(rowbase+(long)t_start*KVBLK)*DM+h*D;
  const bf16*ksrc=Kh+(long)lane*DM+wid*8;
  const bf16*vsrc=Vh+(long)(16*(wid&3)+(lane>>2))*DM+(wid>>2)*32+(lane&3)*8;
  const unsigned kdst=lds0+LDS_K+wid*1024, vdst=lds0+LDS_V+wid*1024;
  #define DMA_K(t,slot) glds16(ksrc+(long)(t)*KVBLK*DM,(unsigned)__builtin_amdgcn_readfirstlane(kdst+(slot)))
  #define DMA_V(t,slot) glds16(vsrc+(long)(t)*KVBLK*DM,(unsigned)__builtin_amdgcn_readfirstlane(vdst+(slot)))
  const int vb0=(int)(lds0+LDS_V)+((lane>>4)&1)*32+(lane&3)*8+(4*hi+((lane&15)>>2))*64;
  const char*Kbase=shm+LDS_K; bf16x8 kf[8];
  const lds_cptr shm3=(lds_cptr)shm; const lds_cptr kp0=shm3+LDS_K+hi*1024+r32*16; const lds_cptr vp0=shm3+LDS_V+((lane>>4)&1)*32+(lane&3)*8+(4*hi+((lane&15)>>2))*64;
  const lds_f* const bq0=blp+4*hi+t_start*KVBLK;
  DMA_K(0,0);DMA_V(0,0);DMA_K(1,SLOTB);
  float mhat=blp[q0+wid*QBLK+r32],l_reg=0.f;f32x16 o[2];o[0]=f32x16{};o[1]=f32x16{};
  const int qrel=wid*QBLK+r32;
  #define CMASK(P0,P1,t) do{int jb_=(t)-(NT-4); if(jb_>=0)cmask(P0,P1,jb_,qrel,hi);}while(0)
  bool resc=false;
  #define BINIT(P0,P1,t) do{ const lds_f* b_=bq0+(t)*KVBLK; _Pragma("unroll") for(int i_=0;i_<4;++i_){ const f32x4v x0_=*(const lds_f4*)(b_+8*i_), x1_=*(const lds_f4*)(b_+32+8*i_); \
      _Pragma("unroll") for(int k_=0;k_<4;++k_){ P0[4*i_+k_]=x0_[k_]-mhat; P1[4*i_+k_]=x1_[k_]-mhat; } } }while(0)
  #define START(P0,P1) do{ const float rm=rowmax(P0,P1); resc=false; \
    { const float dl=__builtin_fmaxf(rm,0.f); mhat=fadd_s(mhat,dl); \
      _Pragma("unroll") for(int r=0;r<16;++r){P0[r]=fsub_s(P0[r],dl);P1[r]=fsub_s(P1[r],dl);} \
      } \
    _Pragma("unroll") for(int r=0;r<16;++r)P0[r]=__builtin_amdgcn_exp2f(P0[r]); }while(0)
  #define RESC() do{ if(resc){ asm volatile("s_waitcnt lgkmcnt(0)":::"memory"); \
      _Pragma("unroll") for(int d_=0;d_<2;++d_) _Pragma("unroll") for(int r=0;r<16;++r)o[d_][r]*=wsf[crow(r,hi)]; } }while(0)
  f32x16 pA0,pA1,pB0,pB1;
  int sl_prev=0,sl_cur=0,sl_next=SLOTB;
  #define ROT() do{sl_prev=sl_cur;sl_cur=sl_next;sl_next=(sl_next==(NSLOT-1)*SLOTB)?0:sl_next+SLOTB;}while(0)
  DMA_K(2,2*SLOTB);
  WAIT_BAR(3);
  BINIT(pA0,pA1,0);
  qkt(pA0,pA1,Kbase,qr,r32,hi);asm volatile("s_nop 15\n\ts_nop 7":"+v"(pA0),"+v"(pA1));CMASK(pA0,pA1,0);
  START(pA0,pA1);
  _Pragma("unroll") for(int r=0;r<16;++r)pA1[r]=__builtin_amdgcn_exp2f(pA1[r]);
  BINIT(pB0,pB1,1);
  WAIT_BAR(0);
  DMA_K(3,0);DMA_V(1,SLOTB);
  ROT();
  kload8(kf,kp0+sl_cur);
  WAIT_BAR(2);
  s16x4 vlo[8],vhi[8]; u32x4 pw0,pw1,pw2,pw3;
  #define PKW(P,B) cvtpk_s(P[B],P[B+1])
  #define PAF(k) __builtin_bit_cast(bf16x8,pw##k)
  #define VFR(i) (bf16x8){vlo[i][0],vlo[i][1],vlo[i][2],vlo[i][3],vhi[i][0],vhi[i][1],vhi[i][2],vhi[i][3]}
  #define PIN(x) asm volatile("":"+v"(x))
  #define MX3(a,b,c) __builtin_fmaxf(__builtin_fmaxf((a),(b)),(c))
  #define GAPA(MF,A0,A1,A2,A3,W0,W1,PW) do{ MF; sacc2+=(f32x2_t){A0,A1}; sacc2+=(f32x2_t){A2,A3}; PIN(sacc2); W0; W1; PIN(PW); SBAR(); }while(0)
  #define EX(v) __builtin_amdgcn_exp2f(v)
  #define GAPB(MF,X,B,XTRA) do{ MF; X[B]=EX(X[B]); X[B+1]=EX(X[B+1]); X[B+2]=EX(X[B+2]); X[B+3]=EX(X[B+3]); PIN(X); XTRA; SBAR(); }while(0)
  #define BLD(dst,off) dst=*(const lds_f4*)(bqn_+(off))
  #define BSB(P,i,src) do{ P[4*(i)]=src[0]-mhat; P[4*(i)+1]=src[1]-mhat; P[4*(i)+2]=src[2]-mhat; P[4*(i)+3]=src[3]-mhat; PIN(P); }while(0)
  #define VRD(i) do{ vlo[i]=vtr(vp_+(((i)>>2)*4096+((i)&3)*1024)); vhi[i]=vtr(vp_+(((i)>>2)*4096+((i)&3)*1024+512)); }while(0)
  #define KRD(G,j) do{ if(G){ kload2(kf,kp0+sl_next,j); SBAR(); } }while(0)
  #define STEP(C0,C1,P0,P1,t,GK,GV,GL) do{ SBAR(); \
    const lds_cptr vp_=vp0+sl_prev; const lds_f* const bqn_=bq0+((t)+1)*KVBLK; f32x4v bta_,btb_; \
    VRD(0); SBAR(); f32x2_t sacc2=(f32x2_t){P0[0],P0[1]}; \
    GAPA(C0=__builtin_amdgcn_mfma_f32_32x32x16_bf16(kf[0],qr[0],C0,0,0,0), P0[2],P0[3],P0[4],P0[5],     pw0[0]=PKW(P0,0), pw0[1]=PKW(P0,2), pw0); \
    VRD(4); SBAR(); GAPA(C1=__builtin_amdgcn_mfma_f32_32x32x16_bf16(kf[1],qr[0],C1,0,0,0), P0[6],P0[7],P0[8],P0[9],     pw0[2]=PKW(P0,4), pw0[3]=PKW(P0,6), pw0); \
    VRD(1); SBAR(); GAPA(C0=__builtin_amdgcn_mfma_f32_32x32x16_bf16(kf[2],qr[1],C0,0,0,0),   P0[10],P0[11],P0[12],P0[13], pw1[0]=PKW(P0,8), pw1[1]=PKW(P0,10), pw1); \
    VRD(5); SBAR(); GAPA(C1=__builtin_amdgcn_mfma_f32_32x32x16_bf16(kf[3],qr[1],C1,0,0,0),   P0[14],P0[15],P1[0],P1[1],   pw1[2]=PKW(P0,12),pw1[3]=PKW(P0,14), pw1); \
    VRD(2); SBAR(); GAPA(C0=__builtin_amdgcn_mfma_f32_32x32x16_bf16(kf[4],qr[2],C0,0,0,0),   P1[2],P1[3],P1[4],P1[5],     pw2[0]=PKW(P1,0), pw2[1]=PKW(P1,2), pw2); \
    VRD(6); SBAR(); GAPA(C1=__builtin_amdgcn_mfma_f32_32x32x16_bf16(kf[5],qr[2],C1,0,0,0),   P1[6],P1[7],P1[8],P1[9],     pw2[2]=PKW(P1,4), pw2[3]=PKW(P1,6), pw2); \
    VRD(3); SBAR(); GAPA(C0=__builtin_amdgcn_mfma_f32_32x32x16_bf16(kf[6],qr[3],C0,0,0,0),   P1[10],P1[11],P1[12],P1[13], pw3[0]=PKW(P1,8), pw3[1]=PKW(P1,10), pw3); \
    VRD(7); SBAR(); GAPA(C1=__builtin_amdgcn_mfma_f32_32x32x16_bf16(kf[7],qr[3],C1,0,0,0),   P1[14],P1[15],0.f,0.f,       pw3[2]=PKW(P1,12),pw3[3]=PKW(P1,14), pw3); \
    l_reg+=sacc2[0]+sacc2[1]; \
    if(GK){DMA_K((t)+3,sl_cur);} if(GV){DMA_V((t)+1,sl_next);} \
    CMASK(C0,C1,t); \
    { float a=MX3(C0[0],C0[1],C1[0]),b=MX3(C0[2],C0[3],C1[1]); a=MX3(a,C1[2],C1[3]); \
      _Pragma("unroll") for(int r=4;r<16;r+=4){a=MX3(a,C0[r],C0[r+1]);b=MX3(b,C0[r+2],C0[r+3]);a=MX3(a,C1[r],C1[r+1]);b=MX3(b,C1[r+2],C1[r+3]);} \
      float rm=__builtin_fmaxf(a,b); { auto rr=__builtin_amdgcn_permlane32_swap(__float_as_uint(rm),__float_as_uint(rm),false,false); rm=__builtin_fmaxf(__uint_as_float(rr[0]),__uint_as_float(rr[1])); } \
      resc=false; \
      if(__builtin_expect(__any(rm>(float)THRL),0)){ const float dl=__builtin_fmaxf(rm,0.f); mhat+=dl; \
        _Pragma("unroll") for(int r=0;r<16;++r){C0[r]-=dl;C1[r]-=dl;} \
        const float f=__builtin_amdgcn_exp2f(-dl); l_reg*=f; if(hi==0)wsf[r32]=f; resc=true; } } \
    SBAR(); \
    GAPB(o[0]=__builtin_amdgcn_mfma_f32_32x32x16_bf16(PAF(0),VFR(0),o[0],0,0,0), C0,0, BLD(bta_,0)); \
    GAPB(o[1]=__builtin_amdgcn_mfma_f32_32x32x16_bf16(PAF(0),VFR(4),o[1],0,0,0), C0,4, BLD(btb_,8);BSB(P0,0,bta_)); \
    KRD(GL,0); GAPB(o[0]=__builtin_amdgcn_mfma_f32_32x32x16_bf16(PAF(1),VFR(1),o[0],0,0,0), C0,8, BLD(bta_,16);BSB(P0,1,btb_)); \
    KRD(GL,1); GAPB(o[1]=__builtin_amdgcn_mfma_f32_32x32x16_bf16(PAF(1),VFR(5),o[1],0,0,0), C0,12, BLD(btb_,24);BSB(P0,2,bta_)); \
    KRD(GL,2); GAPB(o[0]=__builtin_amdgcn_mfma_f32_32x32x16_bf16(PAF(2),VFR(2),o[0],0,0,0), C1,0, BLD(bta_,32);BSB(P0,3,btb_)); \
    KRD(GL,3); GAPB(o[1]=__builtin_amdgcn_mfma_f32_32x32x16_bf16(PAF(2),VFR(6),o[1],0,0,0), C1,4, BLD(btb_,40);BSB(P1,0,bta_)); \
    GAPB(o[0]=__builtin_amdgcn_mfma_f32_32x32x16_bf16(PAF(3),VFR(3),o[0],0,0,0), C1,8, BLD(bta_,48);BSB(P1,1,btb_)); \
    GAPB(o[1]=__builtin_amdgcn_mfma_f32_32x32x16_bf16(PAF(3),VFR(7),o[1],0,0,0), C1,12, BLD(btb_,56);BSB(P1,2,bta_)); \
    BSB(P1,3,btb_); \
    }while(0)
  int t=1;
  #undef CMASK
  #define CMASK(P0,P1,t) do{}while(0)
  for(;t+5<NT;t+=2){
    STEP(pB0,pB1,pA0,pA1,t,true,true,true);     WAIT_BAR(2); RESC(); ROT();
    STEP(pA0,pA1,pB0,pB1,t+1,true,true,true);   WAIT_BAR(2); RESC(); ROT();
  }
  #undef CMASK
  #define CMASK(P0,P1,t) do{int jb_=(t)-(NT-4); if(jb_>=0)cmask(P0,P1,jb_,qrel,hi);}while(0)
  #define ENDW(tt) do{ if((tt)+3<NT){WAIT_BAR(2);} else if((tt)+2<NT){WAIT_BAR(1);} else {WAIT_BAR(0);} }while(0)
  for(;t+1<NT;t+=2){
    STEP(pB0,pB1,pA0,pA1,t,(t+3<NT),(t+1<NT),(t+1<NT));       ENDW(t);   RESC(); ROT();
    STEP(pA0,pA1,pB0,pB1,t+1,(t+4<NT),(t+2<NT),(t+2<NT));     ENDW(t+1); RESC(); ROT();
  }
  STEP(pB0,pB1,pA0,pA1,NT-1,false,false,false); RESC();
  { float sacc=pB0[0]+pB0[1]; _Pragma("unroll") for(int r=2;r<16;++r)sacc+=pB0[r]; _Pragma("unroll") for(int r=0;r<16;++r)sacc+=pB1[r]; l_reg+=sacc;
    pw0=(u32x4){PKW(pB0,0),PKW(pB0,2),PKW(pB0,4),PKW(pB0,6)};pw1=(u32x4){PKW(pB0,8),PKW(pB0,10),PKW(pB0,12),PKW(pB0,14)};pw2=(u32x4){PKW(pB1,0),PKW(pB1,2),PKW(pB1,4),PKW(pB1,6)};pw3=(u32x4){PKW(pB1,8),PKW(pB1,10),PKW(pB1,12),PKW(pB1,14)};
    SBAR(); pv(o,vb0+sl_cur,PAF(0),PAF(1),PAF(2),PAF(3)); }
  #undef PKW
  #undef PAF
  #undef VFR
  #undef PIN
  #undef MX3
  #undef GAPA
  #undef GAPB
  #undef BLD
  #undef BSB
  #undef BINIT
  #undef EX
  #undef VRD
  #undef KRD
  #undef STEP
  #undef ENDW
  {auto rr=__builtin_amdgcn_permlane32_swap(__float_as_uint(l_reg),__float_as_uint(l_reg),false,false);l_reg=__uint_as_float(rr[0])+__uint_as_float(rr[1]);}
  if(hi==0)wsf[32+r32]=l_reg;asm volatile("s_waitcnt lgkmcnt(0)":::"memory");
  float rli[16];
  #pragma unroll
  for(int r=0;r<16;++r)rli[r]=__builtin_amdgcn_rcpf(wsf[32+crow(r,hi)]);
  bf16*Ow=O+(rowbase+q0+wid*QBLK)*DM+h*D;
  { bf16*stg=(bf16*)(shm+LDS_OST)+wid*2048;
    #pragma unroll
    for(int r=0;r<16;++r){const int orow=crow(r,hi);
      #pragma unroll
      for(int d0=0;d0<2;++d0)stg[orow*64+d0*32+r32]=__float2bfloat16(o[d0][r]*rli[r]);}
    asm volatile("s_waitcnt lgkmcnt(0)":::"memory");
    const int ch=lane&7; const bf16*Gw=Gp+(rowbase+q0+wid*QBLK)*DM+h*D;
    const f32x4v ga=*reinterpret_cast<const f32x4v*>(ggrp+h*D+ch*8),gb=*reinterpret_cast<const f32x4v*>(ggrp+h*D+ch*8+4);
    const float gg[8]={ga[0],ga[1],ga[2],ga[3],gb[0],gb[1],gb[2],gb[3]};
    #pragma unroll
    for(int i=0;i<4;++i){const int row=i*8+(lane>>3); const u32x4 v=*(const u32x4*)(stg+row*64+ch*8); const u32x4 gv=*reinterpret_cast<const u32x4*>(Gw+(long)row*DM+ch*8);
      float s=0.f; u32x4 y;
      #pragma unroll
      for(int k=0;k<4;++k){ const float a0=__uint_as_float(v[k]<<16),a1=__uint_as_float(v[k]&0xffff0000u),g0=__uint_as_float(gv[k]<<16),g1=__uint_as_float(gv[k]&0xffff0000u);
        s+=a0*a0+a1*a1; y[k]=cvtpk_s(a0*gg[2*k]*silu2(g0),a1*gg[2*k+1]*silu2(g1)); }
      s+=__shfl_xor(s,1); s+=__shfl_xor(s,2); s+=__shfl_xor(s,4);
      if(ch==0)ssq[(rowbase+q0+wid*QBLK+row)*16+h]=s;
      ATTN_STORE16(Ow+(long)row*DM+ch*8,y);} }
  asm volatile("s_waitcnt lgkmcnt(0)\n\ts_barrier":::"memory");
  #undef DMA_K
  #undef DMA_V
  #undef CMASK
  #undef START
  #undef RESC
  #undef ROT
}
constexpr int ATTN_LDS_BYTES=LDS_BYTES;
constexpr float SB_EXIT=150.f;
__device__ __forceinline__ void sb_unit(int b,int h,int qb,const bf16*Q,const bf16*__restrict__ K,const bf16*__restrict__ VT,bf16*O,const bf16*__restrict__ Gp,const float*__restrict__ ggrp,float*__restrict__ ssq){
  int tid_o=threadIdx.x; asm volatile("":"+v"(tid_o)); const int tid=tid_o,lane=tid&63,r32=lane&31,hi=lane>>5; const int wid=__builtin_amdgcn_readfirstlane(tid>>6);
  const long rowbase=(long)b*SEQ; const int q0=qb*QB+wid*QBLK;
  const bf16*Qw=Q+(rowbase+q0)*DM+h*D;
  const int pi=16*((r32>>2)&1)+(r32&3)+4*(r32>>3);
  const bf16*Kl=K+(rowbase+pi)*DM+h*D+hi*8;
  const bf16*Vl=VT+((long)((b*8+h)*64+r32))*SEQ+16*hi;
  bf16x8 qr[4];
  #pragma unroll
  for(int d0=0;d0<4;++d0)qr[d0]=*reinterpret_cast<const bf16x8*>(&Qw[(long)r32*DM+d0*16+hi*8]);
  f32x16 o0=f32x16{},o1=f32x16{};
  float carry=0.f; const int qabs=q0+r32; const int ktd=q0>>5;
  bf16x8 kc[4],vc[4],kx[4],vx[4];
  #define SB_LOAD(KF,VF,kt_) do{ const bf16*kp_=Kl+(long)(kt_)*32*DM; const bf16*vp_=Vl+(kt_)*32; \
    _Pragma("unroll") for(int d0=0;d0<4;++d0)KF[d0]=*reinterpret_cast<const bf16x8*>(kp_+16*d0); \
    VF[0]=*reinterpret_cast<const bf16x8*>(vp_); VF[1]=*reinterpret_cast<const bf16x8*>(vp_+8); VF[2]=*reinterpret_cast<const bf16x8*>(vp_+32*SEQ); VF[3]=*reinterpret_cast<const bf16x8*>(vp_+32*SEQ+8); }while(0)
  SB_LOAD(kc,vc,ktd);
  for(int kt=ktd;kt>=0;--kt){
    const int kbase=kt*32;
    { const int ktn=kt>0?kt-1:0; SB_LOAD(kx,vx,ktn); }
    f32x16 p=f32x16{};
    p=__builtin_amdgcn_mfma_f32_32x32x16_bf16(kc[0],qr[0],p,0,0,0);p=__builtin_amdgcn_mfma_f32_32x32x16_bf16(kc[1],qr[1],p,0,0,0);
    p=__builtin_amdgcn_mfma_f32_32x32x16_bf16(kc[2],qr[2],p,0,0,0);p=__builtin_amdgcn_mfma_f32_32x32x16_bf16(kc[3],qr[3],p,0,0,0);
    const bool diag=(kt==ktd); const int key0=kbase+16*hi;
    float l2[16];
    #pragma unroll
    for(int r=0;r<16;++r){ const float t=p[r]; float l=__builtin_amdgcn_logf(1.0f+__builtin_amdgcn_exp2f(t)); l=(t>30.f)?t:l;
      if(diag){ if(key0+r>=qabs)l=0.f; } l2[r]=l; }
    float g[4];
    #pragma unroll
    for(int i=0;i<4;++i)g[i]=(l2[4*i]+l2[4*i+1])+(l2[4*i+2]+l2[4*i+3]);
    const float tot=(g[0]+g[1])+(g[2]+g[3]);
    float pt; { auto rr=__builtin_amdgcn_permlane32_swap(__float_as_uint(tot),__float_as_uint(tot),false,false); const unsigned tu=__float_as_uint(tot); pt=__uint_as_float(rr[0]==tu?rr[1]:rr[0]); }
    float suf[4]; suf[3]=carry+(hi?0.f:pt); suf[2]=suf[3]+g[3]; suf[1]=suf[2]+g[2]; suf[0]=suf[1]+g[1];
    carry+=tot+pt;
    float a[16];
    #pragma unroll
    for(int i=0;i<4;++i){ float c=suf[i];
      #pragma unroll
      for(int k=3;k>=0;--k){ const int r=4*i+k; c+=l2[r]; float av=__builtin_amdgcn_exp2f(p[r]-c); if(diag){ if(key0+r>=qabs)av=0.f; } a[r]=av; } }
    u32x4 w0,w1; w0[0]=cvtpk_s(a[0],a[1]);w0[1]=cvtpk_s(a[2],a[3]);w0[2]=cvtpk_s(a[4],a[5]);w0[3]=cvtpk_s(a[6],a[7]);
    w1[0]=cvtpk_s(a[8],a[9]);w1[1]=cvtpk_s(a[10],a[11]);w1[2]=cvtpk_s(a[12],a[13]);w1[3]=cvtpk_s(a[14],a[15]);
    const bf16x8 pa0=__builtin_bit_cast(bf16x8,w0),pa1=__builtin_bit_cast(bf16x8,w1);
    o0=__builtin_amdgcn_mfma_f32_32x32x16_bf16(pa0,vc[0],o0,0,0,0);o1=__builtin_amdgcn_mfma_f32_32x32x16_bf16(pa0,vc[2],o1,0,0,0);
    o0=__builtin_amdgcn_mfma_f32_32x32x16_bf16(pa1,vc[1],o0,0,0,0);o1=__builtin_amdgcn_mfma_f32_32x32x16_bf16(pa1,vc[3],o1,0,0,0);
    if(__all(carry>=SB_EXIT))break;
    #pragma unroll
    for(int d0=0;d0<4;++d0){kc[d0]=kx[d0];vc[d0]=vx[d0];}
  }
  #undef SB_LOAD
  unsigned short*Ow=(unsigned short*)(O+(rowbase+q0)*DM+h*D);
  const unsigned short*Gw=(const unsigned short*)(Gp+(rowbase+q0)*DM+h*D); const float gg0=ggrp[h*D+r32],gg1=ggrp[h*D+32+r32];
  #pragma unroll
  for(int r=0;r<16;++r){ const long ro=(long)crow(r,hi)*DM; const float a0=o0[r],a1=o1[r];
    float s=a0*a0+a1*a1;
    #pragma unroll
    for(int o_=1;o_<32;o_<<=1)s+=__shfl_xor(s,o_);
    if(r32==0)ssq[(rowbase+q0+crow(r,hi))*16+h]=s;
    const float g0=__uint_as_float(((unsigned)Gw[ro+r32])<<16),g1=__uint_as_float(((unsigned)Gw[ro+32+r32])<<16);
    const unsigned w=cvtpk_s(a0*gg0*silu2(g0),a1*gg1*silu2(g1));
    Ow[ro+r32]=(unsigned short)(w&0xffffu); Ow[ro+32+r32]=(unsigned short)(w>>16); }
}
struct AttnTensors { const bf16* Q; const bf16* K; const bf16* V; bf16* O; const float* cum; };

#undef SBAR
#undef WAIT_BAR
}
constexpr int NWAVES = 8;
#ifndef PROBE_DUP
#define PROBE_DUP 0
#endif
#ifndef MK_PER_PHASE
#define MK_PER_PHASE 0
#endif
constexpr int BATCH = 2, T = 8192, D = 1024, DEPTH = 4, NHEADS = 16, HD = 64;
constexpr int M = BATCH * T;
constexpr int D_IN = 4104, NPROJ = 4096;
constexpr float EPS = 1e-6f, LOG2E = 1.4426950408889634f;
constexpr size_t MiB = 1u << 20;
constexpr size_t WS_CTL = 0, CTL_ZERO_BYTES = 256 * 1024;
constexpr size_t WS_BAR = 16 * 1024, WS_QCTR = 32 * 1024, WS_KN = 64 * 1024;
constexpr size_t WS_BAR_UNUSED_ = 0;
constexpr size_t WS_ADA = 512 * 1024;
constexpr size_t WS_LOGF = 1 * MiB;
constexpr size_t WS_CUM = WS_LOGF + 512 * 1024;
constexpr size_t WS_WIN = 2 * MiB;
constexpr size_t WS_WOUT = WS_WIN + (size_t)DEPTH * NPROJ * D * 2;
constexpr size_t WS_XN = 42 * MiB;
constexpr size_t WS_QO = 74 * MiB, WS_K = 106 * MiB, WS_V = 138 * MiB, WS_G = 170 * MiB, WS_O = 202 * MiB, WS_SSQ = 234 * MiB, WS_VT = 235 * MiB, WS_END = 251 * MiB;
static_assert(WS_WOUT + (size_t)DEPTH * D * D * 2 <= WS_XN && WS_XN + (size_t)M * D * 2 <= WS_QO, "d_ws map");
constexpr int RING_BYTES = 131072, LDS_BYTES = 147456, MISC_OFF = RING_BYTES + 320, BARST_OFF = MISC_OFF + 64;
static_assert(attn_body::ATTN_LDS_BYTES <= RING_BYTES, "attention LDS");

#define GAS __attribute__((address_space(1)))
#define LAS __attribute__((address_space(3)))
typedef unsigned short bf16;
typedef unsigned v4u __attribute__((ext_vector_type(4)));
typedef float f32x4 __attribute__((ext_vector_type(4)));
#define LDS_WAIT() asm volatile("s_waitcnt lgkmcnt(0)" ::: "memory")
__device__ __forceinline__ unsigned f2bf(float f) { unsigned u = __builtin_bit_cast(unsigned, f); return (u + 0x7fffu + ((u >> 16) & 1u)) >> 16; }
__device__ __forceinline__ unsigned pk2(float lo, float hi) { return f2bf(lo) | (f2bf(hi) << 16); }
__device__ __forceinline__ float bf_lo(unsigned w) { return __uint_as_float(w << 16); }
__device__ __forceinline__ float bf_hi(unsigned w) { return __uint_as_float(w & 0xffff0000u); }
__device__ __forceinline__ float wave_sum(float v) {
#pragma unroll
    for (int o = 1; o < 64; o <<= 1) v += __shfl_xor(v, o);
    return v;
}
__device__ __forceinline__ void transpose_item(const float* W, int ldw, int k0, int n0, bf16* WT, int ldt, int drow0, LAS float* scr, int lane) {
    float tv[32];
#pragma unroll
    for (int i = 0; i < 32; ++i) tv[i] = W[(size_t)(k0 + 2 * i + (lane >> 5)) * ldw + n0 + (lane & 31)];
#pragma unroll
    for (int i = 0; i < 32; ++i) scr[(2 * i + (lane >> 5)) * 33 + (lane & 31)] = tv[i];
    LDS_WAIT(); asm volatile("" ::: "memory");
    const int c = lane & 7;
#pragma unroll
    for (int j = 0; j < 4; ++j) { const int n = (lane >> 3) + 8 * j; const LAS float* s = scr + (8 * c) * 33 + n;
        v4u o; o.x = pk2(s[0 * 33], s[1 * 33]); o.y = pk2(s[2 * 33], s[3 * 33]); o.z = pk2(s[4 * 33], s[5 * 33]); o.w = pk2(s[6 * 33], s[7 * 33]);
        *(v4u*)(WT + (size_t)(drow0 + n) * ldt + k0 + 8 * c) = o; }
    LDS_WAIT(); asm volatile("" ::: "memory");
}
__device__ __forceinline__ float silu_f(float x) { return x * __builtin_amdgcn_rcpf(1.0f + __builtin_amdgcn_exp2f(-x * LOG2E)); }

#define XB_TMO      128
#define XB_XCNT(j)  (256  + 64 * (j))
#define XB_XSUB(j)  (1280 + 64 * (j))
#define XB_XGEN(j)  (2304 + 64 * (j))
#define XB_TOP      3328
#define XB_TOPGEN   3392
#define XCD_BAR_WORDS 3456
#define XB_SPIN_CAP (1u << 18)

__device__ __forceinline__ unsigned xb_ld(unsigned* p)              { return __hip_atomic_load(p, __ATOMIC_RELAXED, __HIP_MEMORY_SCOPE_AGENT); }
__device__ __forceinline__ unsigned xb_add(unsigned* p, unsigned v) { return __hip_atomic_fetch_add(p, v, __ATOMIC_RELAXED, __HIP_MEMORY_SCOPE_AGENT); }
__device__ __forceinline__ unsigned xb_xcc_id() { return (unsigned)__builtin_amdgcn_s_getreg((3 << 11) | 20) & 0xFu; }
#define XB_SPIN(cond, bar) do { unsigned _sp = 0; while (cond) { __builtin_amdgcn_s_sleep(1); \
    if ((++_sp & 255u) == 0u) { if (xb_ld(&(bar)[XB_TMO])) break; if (_sp > XB_SPIN_CAP) { atomicAdd(&(bar)[XB_TMO], 1u); break; } } } } while (0)

struct XcdBarrier {
    unsigned* bar; unsigned x;
    volatile LAS unsigned* st;
};

__device__ __forceinline__ XcdBarrier xcd_barrier_post(unsigned* bar, volatile LAS unsigned* st) {
    XcdBarrier b; b.bar = bar; b.x = xb_xcc_id(); b.st = st;
    if (threadIdx.x == 0) (void)xb_add(&bar[XB_XCNT(b.x)], 1u);
    return b;
}
__device__ __forceinline__ void xcd_barrier_complete(unsigned* bar, unsigned x, unsigned& nloc, unsigned& nx) {
    const unsigned G = gridDim.x * gridDim.y * gridDim.z;
    unsigned sum, cnt, mine, sp = 0u;
    for (;;) {
        sum = 0u; cnt = 0u; mine = 0u;
#pragma unroll
        for (unsigned j = 0; j < 16; ++j) { const unsigned c = xb_ld(&bar[XB_XCNT(j)]); sum += c; cnt += (c > 0u) ? 1u : 0u; mine = (j == x) ? c : mine; }
        if (sum == G) break;
        __builtin_amdgcn_s_sleep(1);
        if ((++sp & 255u) == 0u) { if (xb_ld(&bar[XB_TMO])) break; if (sp > XB_SPIN_CAP) { atomicAdd(&bar[XB_TMO], 1u); break; } }
    }
    nloc = mine > 0u ? mine : 1u; nx = cnt > 0u ? cnt : 1u;
}

__device__ __forceinline__ void xcd_barrier(const XcdBarrier& b) {
    asm volatile("s_waitcnt vmcnt(0)" ::: "memory");
    __syncthreads();
    if (threadIdx.x == 0) {
        unsigned* bar = b.bar;
        __builtin_amdgcn_s_waitcnt(0);
        unsigned nloc = b.st[0], nx = b.st[1];
        if (nloc == 0u) { xcd_barrier_complete(bar, b.x, nloc, nx); b.st[0] = nloc; b.st[1] = nx; }
        const unsigned old = xb_add(&bar[XB_XSUB(b.x)], 1u);
        const unsigned gen = old / nloc;
        if (old + 1u == (gen + 1u) * nloc) {
            __builtin_amdgcn_fence(__ATOMIC_RELEASE, "agent");
            asm volatile("s_waitcnt vmcnt(0)" ::: "memory");
            const unsigned og = xb_add(&bar[XB_TOP], 1u);
            const unsigned tg = og / nx;
            if (og + 1u == (tg + 1u) * nx) xb_add(&bar[XB_TOPGEN], 1u);
            else XB_SPIN(xb_ld(&bar[XB_TOPGEN]) == tg, bar);
            __builtin_amdgcn_fence(__ATOMIC_ACQUIRE, "agent");
            xb_add(&bar[XB_XGEN(b.x)], 1u);
            asm volatile("s_waitcnt vmcnt(0)" ::: "memory");
        } else {
            XB_SPIN(xb_ld(&bar[XB_XGEN(b.x)]) == gen, bar);
            __builtin_amdgcn_fence(__ATOMIC_ACQUIRE, "agent");
            asm volatile("s_waitcnt vmcnt(0)" ::: "memory");
        }
    }
    __syncthreads();
}

struct Args { const float* in[10]; float* out; unsigned char* ws; int ph_lo, ph_hi; };
constexpr int N_PHASES = 2 + 4 * DEPTH;

__global__ void __launch_bounds__(NWAVES * 64, 2) hyb_fwd(Args args) {
    extern __shared__ __attribute__((aligned(16))) unsigned char lds[];
    LAS unsigned char* const L = (LAS unsigned char*)lds;
#define PHASE_IDS() int tid_o = threadIdx.x; asm volatile("" : "+v"(tid_o)); const int tid = tid_o, lane = tid & 63, wave = __builtin_amdgcn_readfirstlane(tid >> 6); const int gw = vcu * NWAVES + wave; (void)tid; (void)lane; (void)gw
    const int G = gridDim.x; const int bx = blockIdx.x; const int vcu = (G % 8 == 0) ? (bx % 8) * (G / 8) + bx / 8 : bx;
    const int NGW = G * NWAVES;
    unsigned char* const ws = args.ws;
    const float* x_in = args.in[0]; const float* c_in = args.in[1]; const float* w_ada = args.in[2]; const float* b_ada = args.in[3]; const float* g_norm = args.in[4];
    const float* w_in = args.in[5]; const float* b_f = args.in[6]; const float* g_grp = args.in[7]; const float* w_out = args.in[8]; const float* g_final = args.in[9];
    float* const out = args.out;
    float* const ADA = (float*)(ws + WS_ADA); float* const LOGF = (float*)(ws + WS_LOGF); float* const CUM = (float*)(ws + WS_CUM);
    bf16* const WIN = (bf16*)(ws + WS_WIN); bf16* const WOUT = (bf16*)(ws + WS_WOUT); bf16* const XN = (bf16*)(ws + WS_XN);
    bf16* const QO = (bf16*)(ws + WS_QO); bf16* const KB = (bf16*)(ws + WS_K); bf16* const VB = (bf16*)(ws + WS_V); bf16* const GB = (bf16*)(ws + WS_G); bf16* const OB = (bf16*)(ws + WS_O); unsigned* const KN = (unsigned*)(ws + WS_KN); unsigned* const QCTR = (unsigned*)(ws + WS_QCTR); float* const SSQ = (float*)(ws + WS_SSQ); bf16* const VT = (bf16*)(ws + WS_VT);
    const int lo = args.ph_lo, hi_ph = args.ph_hi;
    cg::grid_group grid = cg::this_grid();
    for (int u = threadIdx.x; u < (LDS_BYTES - RING_BYTES) / 4; u += NWAVES * 64) ((LAS unsigned*)(L + RING_BYTES))[u] = 0u;
    __syncthreads();
    XcdBarrier bar = xcd_barrier_post((unsigned*)(ws + WS_BAR), (volatile LAS unsigned*)(L + BARST_OFF));
    if (lo < 0) grid.sync();
#define IN(k) (lo <= (k) && (k) < hi_ph)
#define SEAM(k) do { if (IN(k) && IN((k) + 1)) xcd_barrier(bar); } while (0)

    if (IN(0)) { PHASE_IDS();
        LAS float* scr = (LAS float*)(L + wave * 16384);
        constexpr int I_IN = (D / 64) * (NPROJ / 32), I_OUT = (D / 64) * (D / 32), I_L = I_IN + I_OUT;
        for (int it = gw; it < DEPTH * I_L; it += NGW) {
            const int l = it / I_L; int r = it % I_L;
            if (r < I_IN) { const int kb = r / (NPROJ / 32), db = r % (NPROJ / 32), seg = db >> 4;
                const int sseg = seg == 1 ? 3 : seg == 2 ? 1 : seg == 3 ? 4 : seg == 4 ? 2 : seg;
                transpose_item(w_in + (size_t)l * D * D_IN, D_IN, 64 * kb, sseg * 512 + (db & 15) * 32, WIN + (size_t)l * NPROJ * D, D, 32 * db, scr, lane); }
            else { r -= I_IN; const int kb = r / (D / 32), db = r % (D / 32);
                transpose_item(w_out + (size_t)l * D * D, D, 64 * kb, 32 * db, WOUT + (size_t)l * D * D, D, 32 * db, scr, lane); }
        }
        if (bx < DEPTH * 48) {
            const int l = bx / 48, cb = bx % 48, cl = tid & 15, kg = tid >> 4;
            const float* wp = w_ada + ((size_t)l * D + kg) * (3 * D) + cb * 64 + 4 * cl;
            f32x4 a0 = (f32x4){0.f, 0.f, 0.f, 0.f}, a1 = a0;
#pragma unroll 8
            for (int i = 0; i < 32; ++i) { const f32x4 w = *(const f32x4*)(wp + (size_t)(32 * i) * (3 * D)); const float c0 = silu_f(c_in[kg + 32 * i]), c1 = silu_f(c_in[D + kg + 32 * i]); a0 += w * c0; a1 += w * c1; }
            LAS f32x4* red = (LAS f32x4*)L;
            __syncthreads();
            red[(kg * 2 + 0) * 16 + cl] = a0; red[(kg * 2 + 1) * 16 + cl] = a1;
            __syncthreads();
            if (tid < 32) { const int b = tid >> 4, c2 = tid & 15; f32x4 s = *(const f32x4*)(b_ada + (size_t)l * 3 * D + cb * 64 + 4 * c2);
                for (int k2 = 0; k2 < 32; ++k2) s += red[(k2 * 2 + b) * 16 + c2];
                *(f32x4*)(ADA + ((size_t)l * 2 + b) * 3 * D + cb * 64 + 4 * c2) = s; }
            __syncthreads();
        }
    }
    SEAM(0);

    for (int l = 0; l < DEPTH; ++l) {
        const int pb = 1 + 4 * l;
        const float* xsrc = (l == 0) ? x_in : out;
        const float* ada = ADA + (size_t)l * 2 * 3 * D;
        if (IN(pb)) { PHASE_IDS();
            const float* wf = w_in + (size_t)l * D * D_IN + NPROJ;
            f32x4 wfa[4][4][2], gv[4];
#pragma unroll
            for (int j = 0; j < 4; ++j) { gv[j] = *(const f32x4*)(g_norm + l * D + 4 * lane + 256 * j);
#pragma unroll
                for (int c = 0; c < 4; ++c) { const float* p = wf + (size_t)(4 * lane + 256 * j + c) * D_IN; wfa[j][c][0] = *(const f32x4*)p; wfa[j][c][1] = *(const f32x4*)(p + 4); } }
            const float bfl = (lane < 8) ? b_f[l * 8 + lane] : 0.f;
            f32x4 v[4], vn[4];
#pragma unroll
            for (int j = 0; j < 4; ++j) { v[j] = *(const f32x4*)(xsrc + (size_t)gw * D + 4 * lane + 256 * j); vn[j] = *(const f32x4*)(xsrc + (size_t)(gw + NGW < M ? gw + NGW : gw) * D + 4 * lane + 256 * j); }
            for (int m = gw; m < M; m += NGW) {
                const float* ab = ada + (size_t)(m / T) * 3 * D;
                f32x4 vn2[4]; const int mn = (m + 2 * NGW < M) ? m + 2 * NGW : m;
#pragma unroll
                for (int j = 0; j < 4; ++j) vn2[j] = *(const f32x4*)(xsrc + (size_t)mn * D + 4 * lane + 256 * j);
                float ss = 0.f;
#pragma unroll
                for (int j = 0; j < 4; ++j) ss += (v[j].x * v[j].x + v[j].y * v[j].y) + (v[j].z * v[j].z + v[j].w * v[j].w);
                const float rstd = 1.0f / sqrtf(wave_sum(ss) * (1.f / D) + EPS);
                float f[8];
#pragma unroll
                for (int k = 0; k < 8; ++k) f[k] = 0.f;
#pragma unroll
                for (int j = 0; j < 4; ++j) { const f32x4 sh = *(const f32x4*)(ab + 4 * lane + 256 * j), sc = *(const f32x4*)(ab + D + 4 * lane + 256 * j);
                    const f32x4 hh = (v[j] * rstd) * gv[j] * (sc + 1.0f) + sh;
                    *(unsigned long long*)(XN + (size_t)m * D + 4 * lane + 256 * j) = (unsigned long long)pk2(hh.x, hh.y) | ((unsigned long long)pk2(hh.z, hh.w) << 32);
#pragma unroll
                    for (int c = 0; c < 4; ++c) {
#pragma unroll
                        for (int k = 0; k < 4; ++k) { f[k] += hh[c] * wfa[j][c][0][k]; f[4 + k] += hh[c] * wfa[j][c][1][k]; } } }
#pragma unroll
                for (int k = 0; k < 8; ++k) f[k] = wave_sum(f[k]);
                float fv = f[0];
#pragma unroll
                for (int k = 1; k < 8; ++k) fv = (lane == k) ? f[k] : fv;
                if (lane < 8) { const float tt = -(fv + bfl) * LOG2E;
                    const float lf = (tt > 30.f) ? -tt : -__builtin_amdgcn_logf(1.0f + __builtin_amdgcn_exp2f(tt));
                    LOGF[(size_t)m * 8 + lane] = lf; }
#pragma unroll
                for (int j = 0; j < 4; ++j) { v[j] = vn[j]; vn[j] = vn2[j]; }
            }
        }
        SEAM(pb);
        if (IN(pb + 1)) {
            if (bx < BATCH * 8) { PHASE_IDS();
                const int b = bx >> 3, h8 = bx & 7; LAS float* wt = (LAS float*)(L + MISC_OFF);
                float pv[16]; float run = 0.f;
#pragma unroll
                for (int i = 0; i < 16; ++i) { run += LOGF[((size_t)b * T + 16 * tid + i) * 8 + h8]; pv[i] = run; }
                float inc = run;
#pragma unroll
                for (int o = 1; o < 64; o <<= 1) { const float t = __shfl_up(inc, o); if (lane >= o) inc += t; }
                if (lane == 63) wt[wave] = inc;
                __syncthreads();
                float off = inc - run;
                for (int w = 0; w < wave; ++w) off += wt[w];
#pragma unroll
                for (int i = 0; i < 16; ++i) CUM[(size_t)bx * T + 16 * tid + i] = off + pv[i];
                __syncthreads();
            }
            pg8::Gemm g{XN, WIN + (size_t)l * NPROJ * D, M, NPROJ, D}; pg8::StaticOrder S; S.init(M, NPROJ, G, bx);
            pg8::EpiBf16<0> E{VT, 2, 512, KN + (size_t)l * 16 * 128 * 2, 1, 512, T, QO, D, nullptr, D, (size_t)(WS_K - WS_QO) / 2, attn_body::C2};
            pg8::gemm_phase<pg8::EpiBf16<0>, pg8::StaticOrder, PG8_ALIGN, PG8_SP2>(L, g, S, E);
        }
        SEAM(pb + 1);
        if (IN(pb + 2)) {
            const attn_body::bf16* Qp = (const attn_body::bf16*)QO; const attn_body::bf16* Kp = (const attn_body::bf16*)KB; const attn_body::bf16* Vp = (const attn_body::bf16*)VB;
            const float* ggl = g_grp + (size_t)l * D;
            volatile LAS unsigned* const qw = (volatile LAS unsigned*)(L + MISC_OFF + 32);
            const int xq0 = bx & 7; bool own = true;
            for (;;) {
                __syncthreads();
                if (threadIdx.x < 64) { const int ln = threadIdx.x; unsigned idx = 0xffffffffu; int qsel = xq0;
                    if (own) { unsigned r = 0u; if (ln == 0) r = atomicAdd(QCTR + (size_t)(l * 8 + xq0) * 64, 1u); r = (unsigned)__builtin_amdgcn_readfirstlane((int)r); if (r < 128u) idx = r; else own = false; }
                    if (!own && idx == 0xffffffffu) {
                        for (;;) {
                            const unsigned c = (ln < 8) ? __hip_atomic_load(QCTR + (size_t)(l * 8 + ln) * 64, __ATOMIC_RELAXED, __HIP_MEMORY_SCOPE_AGENT) : 128u;
                            const unsigned a8 = (unsigned)__ballot(c < 128u) & 0xffu;
                            if (!a8) break;
                            const unsigned rot = ((a8 >> xq0) | (a8 << (8 - xq0))) & 0xffu; const int q = (xq0 + __builtin_ctz(rot)) & 7;
                            unsigned r = 0u; if (ln == 0) r = atomicAdd(QCTR + (size_t)(l * 8 + q) * 64, 1u); r = (unsigned)__builtin_amdgcn_readfirstlane((int)r);
                            if (r < 128u) { idx = r; qsel = q; break; }
                        } }
                    if (ln == 0) { qw[0] = idx; qw[1] = (unsigned)qsel; } }
                __syncthreads();
                const unsigned idx = qw[0]; const int xq = (int)qw[1], qb_ = xq >> 2, pr = xq & 3;
                if (idx >= 128u) break;
                if (idx < 64u) { const int h8 = (idx & 1u) ? pr : 7 - pr, qb = 31 - (int)(idx >> 1), bh = qb_ * 8 + h8;
                    attn_body::attn_unit<8>(qb_, 8 + h8, qb, Qp, Kp, Vp, (attn_body::bf16*)OB, CUM + (size_t)bh * T, KN + ((size_t)l * 16 + bh) * 256, (const attn_body::bf16*)GB, ggl, SSQ, (char*)lds); }
                else { const unsigned j2 = idx - 64u; attn_body::sb_unit(qb_, 2 * pr + (int)(j2 & 1u), 31 - (int)(j2 >> 1), Qp, Kp, (const attn_body::bf16*)VT, (attn_body::bf16*)OB, (const attn_body::bf16*)GB, ggl, SSQ); }
            }
        }
        SEAM(pb + 2);
        if (IN(pb + 3)) {
            pg8::Gemm g{OB, WOUT + (size_t)l * D * D, M, D, D}; pg8::StaticOrder S; S.init(M, D, G, bx);
            pg8::EpiRes E{xsrc, out, D, ada + 2 * D, T, 3 * D, SSQ, EPS};
            pg8::gemm_phase<pg8::EpiRes, pg8::StaticOrder, PG8_ALIGN, PG8_SP2>(L, g, S, E);
        }
        SEAM(pb + 3);
    }
    if (IN(N_PHASES - 1)) { PHASE_IDS();
        f32x4 gv[4];
#pragma unroll
        for (int j = 0; j < 4; ++j) gv[j] = *(const f32x4*)(g_final + 4 * lane + 256 * j);
        f32x4 v[4];
#pragma unroll
        for (int j = 0; j < 4; ++j) v[j] = *(const f32x4*)(out + (size_t)gw * D + 4 * lane + 256 * j);
        for (int m = gw; m < M; m += NGW) {
            f32x4 vn[4]; const int mn = (m + NGW < M) ? m + NGW : m; float ss = 0.f;
#pragma unroll
            for (int j = 0; j < 4; ++j) vn[j] = *(const f32x4*)(out + (size_t)mn * D + 4 * lane + 256 * j);
#pragma unroll
            for (int j = 0; j < 4; ++j) ss += (v[j].x * v[j].x + v[j].y * v[j].y) + (v[j].z * v[j].z + v[j].w * v[j].w);
            const float rstd = 1.0f / sqrtf(wave_sum(ss) * (1.f / D) + EPS);
#pragma unroll
            for (int j = 0; j < 4; ++j) *(f32x4*)(out + (size_t)m * D + 4 * lane + 256 * j) = (v[j] * rstd) * gv[j];
#pragma unroll
            for (int j = 0; j < 4; ++j) v[j] = vn[j];
        }
    }
#undef IN
#undef SEAM
}

extern "C" void kernel_launch(void* const* d_in, const int* in_sizes, int n_in, void* d_out, int out_size, void* d_ws, size_t ws_size, hipStream_t stream) {
    static int grid = 0;
    if (grid == 0) {
        if (n_in != 10 || in_sizes[0] != M * D || out_size != M * D || ws_size < WS_END) { fprintf(stderr, "kernel_launch: unexpected shapes (n_in %d, in0 %d, out %d, ws %zu)\n", n_in, n_in > 0 ? in_sizes[0] : -1, out_size, ws_size); grid = -1; return; }
        int dev = 0, cus = 0, per_cu = 0;
        if (hipGetDevice(&dev) != hipSuccess || hipDeviceGetAttribute(&cus, hipDeviceAttributeMultiprocessorCount, dev) != hipSuccess) { grid = -1; return; }
        if (hipFuncSetAttribute((const void*)hyb_fwd, hipFuncAttributeMaxDynamicSharedMemorySize, LDS_BYTES) != hipSuccess) { fprintf(stderr, "kernel_launch: hipFuncSetAttribute failed\n"); grid = -1; return; }
        if (hipOccupancyMaxActiveBlocksPerMultiprocessor(&per_cu, (const void*)hyb_fwd, NWAVES * 64, LDS_BYTES) != hipSuccess || per_cu < 1) { fprintf(stderr, "kernel_launch: occupancy query says %d\n", per_cu); per_cu = 1; }
        (void)hipGetLastError();
        grid = cus * 1;
    }
    if (grid < 0) return;
    if (hipMemsetAsync((char*)d_ws + WS_CTL, 0, CTL_ZERO_BYTES, stream) != hipSuccess) { fprintf(stderr, "kernel_launch: memset failed\n"); return; }
    Args a{};
    for (int i = 0; i < 10; ++i) a.in[i] = (const float*)d_in[i];
    a.out = (float*)d_out; a.ws = (unsigned char*)d_ws;
#if MK_PER_PHASE
    for (int p = 0; p < N_PHASES; ++p) { a.ph_lo = p; a.ph_hi = p + 1; void* kargs[] = {&a};
        hipError_t e = hipLaunchCooperativeKernel((const void*)hyb_fwd, dim3(grid), dim3(NWAVES * 64), kargs, LDS_BYTES, stream);
        if (e != hipSuccess) { fprintf(stderr, "kernel_launch: launch of phase %d failed: %s\n", p, hipGetErrorString(e)); break; } }
#else
    a.ph_lo = 0; a.ph_hi = N_PHASES; void* kargs[] = {&a};
    hipError_t e = hipLaunchCooperativeKernel((const void*)hyb_fwd, dim3(grid), dim3(NWAVES * 64), kargs, LDS_BYTES, stream);
    if (e != hipSuccess) fprintf(stderr, "kernel_launch: cooperative launch failed: %s (grid %d)\n", hipGetErrorString(e), grid);
#endif
}
```

```cpp
#include <hip/hip_runtime.h>
#include <hip/hip_cooperative_groups.h>
#include <cstdio>
#include <cstdint>
namespace cg = cooperative_groups;
namespace pg8 {
#define PG8_LAS __attribute__((address_space(3)))
typedef unsigned short bf16_t;
typedef short bf16x8 __attribute__((ext_vector_type(8)));
typedef float f32x4 __attribute__((ext_vector_type(4)));
typedef unsigned u32x4 __attribute__((ext_vector_type(4)));
constexpr int BM = 256, BK = 64, HALF = 128, HTB = HALF * BK * 2  , STAGE_BYTES = 8 * HTB, NXCD = 8, WGM = 8;

__host__ __device__ __forceinline__ int lds_byte(int r, int c) { const int st = (r >> 4) * 2 + (c >> 5), rr = r & 15, cc = c & 31, ob = rr * 64 + cc * 2; return st * 1024 + (ob ^ (((ob >> 9) & 1) << 5)); }
__host__ __device__ __forceinline__ void stage_rc(int b, int& R, int& C) { const int st = b / 1024, sb = b % 1024, swz = sb ^ (((sb >> 9) & 1) << 5); R = (st >> 1) * 16 + swz / 64; C = (st & 1) * 32 + (swz % 64) / 2; }
__host__ __device__ __forceinline__ int perm32(int rho) { const int n = rho >> 4, i = rho & 15; return 8 * (i >> 2) + 4 * n + (i & 3); }

struct Unit { int pm, pn; };
struct Gemm { const bf16_t* A; const bf16_t* Bt; int M, N, K; };

struct StaticOrder {
    int nM, nN, nwg, G, c;
    __host__ __device__ void init(int M, int N, int G_, int c_) { nM = M / BM; nN = N / BM; nwg = nM * nN; G = G_; c = c_; }
    __host__ __device__ bool next(int i, Unit& u) const {
        const long L = (long)i * G + c; if (L >= nwg) return false;
        int wgid = (int)L; { const int q = nwg / NXCD, r = nwg % NXCD, xcd = wgid % NXCD, off = wgid / NXCD; wgid = (xcd < r ? xcd * (q + 1) : r * (q + 1) + (xcd - r) * q) + off; }
        const int nig = WGM * nN, gid = wgid / nig, fm = gid * WGM, gsz = (nM - fm) < WGM ? (nM - fm) : WGM;
        u.pm = fm + ((wgid % nig) % gsz); u.pn = (wgid % nig) / gsz; return true;
    }
    __device__ __forceinline__ void a_ready(const Unit&) const {}
    __device__ __forceinline__ void done(const Unit&) const {}
};

__device__ __forceinline__ unsigned cvt_pk_bf16(float lo, float hi) { unsigned r; asm volatile("v_cvt_pk_bf16_f32 %0, %1, %2" : "=v"(r) : "v"(lo), "v"(hi)); return r; }
typedef float f32x2 __attribute__((ext_vector_type(2)));
__device__ __forceinline__ f32x2 gelu_pk(f32x2 v) {
    const f32x2 av = __builtin_elementwise_abs(v), d = av * 0.2316418882f + 1.0f;
    f32x2 t; t.x = __builtin_amdgcn_rcpf(d.x); t.y = __builtin_amdgcn_rcpf(d.y);
    f32x2 q = t * 0.5307027145f + (-0.7265760135f); q = q * t + 0.7107068705f; q = q * t + (-0.142248368f); q = q * t + 0.127414796f; q = q * t;
    const f32x2 s = (v * v) * (-0.72134752044f);
    f32x2 e; e.x = __builtin_amdgcn_exp2f(s.x); e.y = __builtin_amdgcn_exp2f(s.y);
    const f32x2 m = v * (q * e), r = v - m;
    f32x2 o; o.x = v.x < 0.f ? m.x : r.x; o.y = v.y < 0.f ? m.y : r.y; return o;
}

template <int ACT  > struct EpiBf16 {
    static constexpr bool PERM = true, AFTER_DRAIN = false, MID = false; static_assert(ACT == 0 || ACT == 1, "EpiBf16: ACT is 0 (none) or 1 (gelu_pk)");
    bf16_t* vt; int vt_tile, vt_cols;
    unsigned* kn; int kn_tile, kn_col0, kn_rows;
    bf16_t* O; int ldc; const float* bias; int split_cols; size_t split_stride; float scale0;
    __device__ __forceinline__ void operator()(const f32x4 (&acc)[2][2][4][2], const Unit& u, int wr, int wc, int fr, int fq) const {
        const int row0 = u.pm * BM + wr * 64 + fr; int colt = u.pn * BM; bf16_t* base = O;
        float sc = 1.f; int tsp = 0; if (split_cols) { const int t = colt / split_cols; tsp = t; base += (size_t)t * split_stride; colt -= t * split_cols; if (t == 0) sc = scale0; }
        if (kn && tsp == kn_tile && colt >= kn_col0) {
#pragma unroll
            for (int ai = 0; ai < 2; ++ai)
#pragma unroll
                for (int bj = 0; bj < 2; ++bj) { float mx = 0.f;
#pragma unroll
                    for (int m = 0; m < 4; ++m) { const f32x4 a = acc[ai][bj][m][0], b = acc[ai][bj][m][1]; float s = (a[0] * a[0] + a[1] * a[1]) + (a[2] * a[2] + a[3] * a[3]) + (b[0] * b[0] + b[1] * b[1]) + (b[2] * b[2] + b[3] * b[3]);
                        s += __shfl_xor(s, 16); s += __shfl_xor(s, 32); mx = __builtin_fmaxf(mx, s); }
                    mx = __builtin_fmaxf(mx, __shfl_xor(mx, 1)); mx = __builtin_fmaxf(mx, __shfl_xor(mx, 2)); mx = __builtin_fmaxf(mx, __shfl_xor(mx, 4)); mx = __builtin_fmaxf(mx, __shfl_xor(mx, 8));
                    if (fr == 0 && fq == 0) { const int r0 = u.pm * BM + ai * HALF + wr * 64, bb = r0 / kn_rows, tile = (r0 % kn_rows) >> 6, h8 = (colt - kn_col0 + bj * HALF + wc * 32) >> 6;
                        atomicMax(kn + ((size_t)(bb * 8 + h8) * 128 + tile) * 2 + (wc & 1), __float_as_uint(mx)); } }
        }
        const int col0 = colt + wc * 32 + 8 * fq, bcol0 = u.pn * BM + wc * 32 + 8 * fq;
        f32x4 bv[2][2];
#pragma unroll
        for (int bj = 0; bj < 2; ++bj)
#pragma unroll
            for (int n = 0; n < 2; ++n) bv[bj][n] = bias ? *(const f32x4*)(bias + bcol0 + bj * HALF + 4 * n) : (f32x4){0.f, 0.f, 0.f, 0.f};
#pragma unroll
        for (int ai = 0; ai < 2; ++ai)
#pragma unroll
            for (int m = 0; m < 4; ++m) { bf16_t* rowp = base + (size_t)(row0 + ai * HALF + m * 16) * ldc + col0;
#pragma unroll
                for (int bj = 0; bj < 2; ++bj) { f32x4 v0 = acc[ai][bj][m][0] + bv[bj][0], v1 = acc[ai][bj][m][1] + bv[bj][1];
                    if (ACT == 1) { f32x2 a = gelu_pk((f32x2){v0[0], v0[1]}), b = gelu_pk((f32x2){v0[2], v0[3]}), c = gelu_pk((f32x2){v1[0], v1[1]}), d = gelu_pk((f32x2){v1[2], v1[3]});
                        v0 = (f32x4){a.x, a.y, b.x, b.y}; v1 = (f32x4){c.x, c.y, d.x, d.y}; }
                    v0 = v0 * sc; v1 = v1 * sc; u32x4 w; w.x = cvt_pk_bf16(v0[0], v0[1]); w.y = cvt_pk_bf16(v0[2], v0[3]); w.z = cvt_pk_bf16(v1[0], v1[1]); w.w = cvt_pk_bf16(v1[2], v1[3]);
                    *(u32x4*)(rowp + bj * HALF) = w;
                    if (vt && tsp == vt_tile && colt < vt_cols) { const int row = row0 + ai * HALF + m * 16, c0 = col0 + bj * HALF; bf16_t* tp = vt + ((size_t)((row / kn_rows) * 8 + (c0 >> 6)) * 64 + (c0 & 63)) * kn_rows + (row % kn_rows);
#pragma unroll
                        for (int j = 0; j < 4; ++j) { tp[(size_t)(2 * j) * kn_rows] = (bf16_t)(w[j] & 0xffffu); tp[(size_t)(2 * j + 1) * kn_rows] = (bf16_t)(w[j] >> 16); } } } }
    }
};
struct EpiRes {
    static constexpr bool PERM = false, AFTER_DRAIN = false, MID = true;
    const float* base; float* out; int ldc; const float* gate; int rows_per_batch; int ldg; const float* ssq; float eps;
    __device__ __forceinline__ void group_ms(int row, float& m0, float& m1) const {
        const f32x4* p = (const f32x4*)(ssq + (size_t)row * 16); const f32x4 a = p[0], b = p[1], c = p[2], d = p[3];
        m0 = (((a[0] + a[1]) + (a[2] + a[3])) + ((b[0] + b[1]) + (b[2] + b[3]))) * (1.f / 512.f) + eps;
        m1 = (((c[0] + c[1]) + (c[2] + c[3])) + ((d[0] + d[1]) + (d[2] + d[3]))) * (1.f / 512.f) + eps; }
    __device__ __forceinline__ void mid(f32x4 (&acc)[2][2][4][2], const Unit& u, int wr, int fr) const {
#pragma unroll
        for (int ai = 0; ai < 2; ++ai)
#pragma unroll
            for (int m = 0; m < 4; ++m) { float m0, m1; group_ms(u.pm * BM + ai * HALF + wr * 64 + m * 16 + fr, m0, m1); const float ratio = sqrtf(m1 / m0);
#pragma unroll
                for (int bj = 0; bj < 2; ++bj)
#pragma unroll
                    for (int n = 0; n < 2; ++n) acc[ai][bj][m][n] = acc[ai][bj][m][n] * ratio; }
    }
    __device__ __forceinline__ void operator()(const f32x4 (&acc)[2][2][4][2], const Unit& u, int wr, int wc, int fr, int fq) const {
        const int col0 = u.pn * BM + wc * 32 + 4 * fq;
        const float* gp = gate + (size_t)((u.pm * BM) / rows_per_batch) * ldg + col0;
        f32x4 gv[2][2];
#pragma unroll
        for (int bj = 0; bj < 2; ++bj)
#pragma unroll
            for (int n = 0; n < 2; ++n) gv[bj][n] = *(const f32x4*)(gp + bj * HALF + n * 16) + 1.0f;
#pragma unroll
        for (int ai = 0; ai < 2; ++ai)
#pragma unroll
            for (int m = 0; m < 4; ++m) { const int row = u.pm * BM + ai * HALF + wr * 64 + m * 16 + fr; const size_t off = (size_t)row * ldc + col0;
                float m0, m1; group_ms(row, m0, m1); const float rfx = 1.0f / sqrtf(m1);
#pragma unroll
                for (int bj = 0; bj < 2; ++bj)
#pragma unroll
                    for (int n = 0; n < 2; ++n) { const f32x4 bs = *(const f32x4*)(base + off + bj * HALF + n * 16);
                        *(f32x4*)(out + off + bj * HALF + n * 16) = bs + gv[bj][n] * (acc[ai][bj][m][n] * rfx); }
                if (m & 1) asm volatile("" ::: "memory"); }
    }
};

template <class Epi, class Sched, bool ALIGN_EPI = false, bool SP2 = false>
__device__ __forceinline__ void gemm_phase(PG8_LAS unsigned char* lds, const Gemm g, const Sched& S, const Epi& E) {
    int tid_o = threadIdx.x; asm volatile("" : "+v"(tid_o));
    const int tid = tid_o, wid = __builtin_amdgcn_readfirstlane(tid >> 6), lane = tid & 63, wr = wid >> 2, wc = wid & 3, fr = lane & 15, fq = lane >> 4;
    const int K = g.K, nt = K / BK;
    unsigned voffA[2], voffB[2];
#pragma unroll
    for (int i = 0; i < 2; ++i) { int R, C; stage_rc(tid * 16 + i * 8192, R, C); const int Rb = Epi::PERM ? ((R & ~31) + perm32(R & 31)) : R;
        voffA[i] = (unsigned)(R * K + C) * 2u; voffB[i] = (unsigned)(Rb * K + C) * 2u; }
    const size_t kstep = (size_t)(BK * 2);
    const size_t hstep = (size_t)HALF * K * 2;
    const size_t tstep = 2 * hstep;
    const unsigned ldsw = (unsigned)wid * 1024u;
    const int aoff = lds_byte(wr * 64 + fr, fq * 8), boff = lds_byte(wc * 32 + fr, fq * 8);
#define PG8_SA(b, h) (((b) * 2 + (h)) * HTB)
#define PG8_SB(b, h) ((4 + (b) * 2 + (h)) * HTB)
#define PG8_STAGE(bufoff, gbase, voff) do { _Pragma("unroll") for (int _i = 0; _i < 2; ++_i) \
        __builtin_amdgcn_global_load_lds((const unsigned*)((const char*)(gbase) + (voff)[_i]), (PG8_LAS unsigned*)(lds + (bufoff) + ldsw + _i * 8192), 16, 0, 0); } while (0)
#define PG8_LDA(dst, b, h) do { _Pragma("unroll") for (int m = 0; m < 4; ++m) _Pragma("unroll") for (int k = 0; k < 2; ++k) dst[m][k] = *(const PG8_LAS bf16x8*)(lds + PG8_SA(b, h) + aoff + m * 2048 + k * 1024); } while (0)
#define PG8_LDB(dst, b, h) do { _Pragma("unroll") for (int n = 0; n < 2; ++n) _Pragma("unroll") for (int k = 0; k < 2; ++k) dst[n][k] = *(const PG8_LAS bf16x8*)(lds + PG8_SB(b, h) + boff + n * 2048 + k * 1024); } while (0)
#define PG8_MMA(ai, bj, At, Bt) do { __builtin_amdgcn_s_setprio(1); _Pragma("unroll") for (int m = 0; m < 4; ++m) _Pragma("unroll") for (int n = 0; n < 2; ++n) _Pragma("unroll") for (int k = 0; k < 2; ++k) \
        acc[ai][bj][m][n] = __builtin_amdgcn_mfma_f32_16x16x32_bf16(Bt[n][k], At[m][k], acc[ai][bj][m][n], 0, 0, 0); __builtin_amdgcn_s_setprio(0); } while (0)
#define PG8_WAIT_V(n) asm volatile("s_waitcnt vmcnt(" #n ")" ::: "memory")
#define PG8_WAIT_L(n) asm volatile("s_waitcnt lgkmcnt(" #n ")" ::: "memory")
#define PG8_BAR __builtin_amdgcn_s_barrier()
#define PG8_SCHED __builtin_amdgcn_sched_barrier(0)
    Unit cur, nxt; int ui = 0;
    if (!S.next(0, cur)) return;
    f32x4 acc[2][2][4][2];
#pragma unroll
    for (int a = 0; a < 2; ++a)
#pragma unroll
        for (int b = 0; b < 2; ++b)
#pragma unroll
            for (int m = 0; m < 4; ++m)
#pragma unroll
                for (int n = 0; n < 2; ++n) acc[a][b][m][n] = (f32x4){0.f, 0.f, 0.f, 0.f};
    bf16x8 At[4][2], B0[2][2], B1[2][2];
    const char* cA = (const char*)g.A + (size_t)cur.pm * tstep; const char* cB = (const char*)g.Bt + (size_t)cur.pn * tstep;
    S.a_ready(cur);
    if constexpr (SP2) {
        PG8_STAGE(PG8_SB(0, 0), cB, voffB); PG8_STAGE(PG8_SB(0, 1), cB + hstep, voffB); PG8_STAGE(PG8_SA(0, 0), cA, voffA); PG8_STAGE(PG8_SA(0, 1), cA + hstep, voffA);
        if (wr == 1) PG8_BAR;
        PG8_WAIT_V(2); PG8_BAR;
        PG8_STAGE(PG8_SB(1, 0), cB + kstep, voffB); PG8_STAGE(PG8_SA(1, 0), cA + kstep, voffA); PG8_STAGE(PG8_SB(1, 1), cB + hstep + kstep, voffB);
        PG8_WAIT_V(6); PG8_BAR;
    } else {
        PG8_STAGE(PG8_SB(0, 0), cB, voffB); PG8_STAGE(PG8_SA(0, 0), cA, voffA); PG8_STAGE(PG8_SB(0, 1), cB + hstep, voffB); PG8_STAGE(PG8_SA(0, 1), cA + hstep, voffA);
        if (wr == 1) PG8_BAR;
        PG8_WAIT_V(4); PG8_BAR;
        PG8_STAGE(PG8_SB(1, 0), cB + kstep, voffB); PG8_STAGE(PG8_SA(1, 0), cA + kstep, voffA); PG8_STAGE(PG8_SB(1, 1), cB + hstep + kstep, voffB);
        PG8_WAIT_V(6); PG8_BAR;
    }
    for (;;) {
        const bool has_next = S.next(ui + 1, nxt);
        const char* nA = has_next ? (const char*)g.A + (size_t)nxt.pm * tstep : cA; const char* nB = has_next ? (const char*)g.Bt + (size_t)nxt.pn * tstep : cB;
        for (int t = 0; t < nt; t += 2) {
            if constexpr (Epi::MID) { if (t == nt / 2) E.mid(acc, cur, wr, fr); }
            const bool last = (t == nt - 2);
            const char* a1 = cA + (size_t)(t + 1) * kstep;
            const char* a2 = last ? nA : cA + (size_t)(t + 2) * kstep; const char* b2 = last ? nB : cB + (size_t)(t + 2) * kstep;
            const char* a3 = a2 + kstep; const char* b3 = b2 + kstep;
            if (last && has_next) S.a_ready(nxt);
            if constexpr (SP2) {
            PG8_LDB(B0, 0, 0); PG8_LDB(B1, 0, 1); PG8_SCHED; PG8_LDA(At, 0, 0); PG8_STAGE(PG8_SA(1, 1), a1 + hstep, voffA);
            PG8_WAIT_V(8); PG8_WAIT_L(0); PG8_BAR; PG8_MMA(0, 0, At, B0); PG8_MMA(0, 1, At, B1); PG8_BAR; PG8_SCHED;
            PG8_LDA(At, 0, 1); PG8_STAGE(PG8_SB(0, 0), b2, voffB); PG8_STAGE(PG8_SB(0, 1), b2 + hstep, voffB); PG8_STAGE(PG8_SA(0, 0), a2, voffA);
            PG8_WAIT_V(8); PG8_WAIT_L(0); PG8_BAR; PG8_MMA(1, 0, At, B0); PG8_MMA(1, 1, At, B1); PG8_BAR; PG8_SCHED;
            PG8_LDB(B0, 1, 0); PG8_LDB(B1, 1, 1); PG8_SCHED; PG8_LDA(At, 1, 0); PG8_STAGE(PG8_SA(0, 1), a2 + hstep, voffA);
            PG8_WAIT_V(8); PG8_WAIT_L(0); PG8_BAR; PG8_MMA(0, 0, At, B0); PG8_MMA(0, 1, At, B1); PG8_BAR; PG8_SCHED;
            PG8_LDA(At, 1, 1); PG8_STAGE(PG8_SB(1, 0), b3, voffB); PG8_STAGE(PG8_SB(1, 1), b3 + hstep, voffB); PG8_STAGE(PG8_SA(1, 0), a3, voffA);
            PG8_WAIT_V(8); PG8_WAIT_L(0); PG8_BAR; PG8_MMA(1, 0, At, B0); PG8_MMA(1, 1, At, B1); PG8_BAR; PG8_SCHED;
            } else {
            PG8_LDB(B0, 0, 0); PG8_SCHED; PG8_LDA(At, 0, 0); PG8_STAGE(PG8_SA(1, 1), a1 + hstep, voffA);
            PG8_WAIT_L(8); PG8_BAR; PG8_WAIT_L(0); PG8_MMA(0, 0, At, B0); PG8_BAR; PG8_SCHED;
            PG8_LDB(B1, 0, 1); PG8_STAGE(PG8_SB(0, 0), b2, voffB);
            PG8_BAR; PG8_WAIT_L(0); PG8_MMA(0, 1, At, B1); PG8_BAR;
            PG8_LDA(At, 0, 1); PG8_STAGE(PG8_SA(0, 0), a2, voffA);
            PG8_BAR; PG8_WAIT_L(0); PG8_MMA(1, 0, At, B0); PG8_BAR; PG8_SCHED;
            PG8_STAGE(PG8_SB(0, 1), b2 + hstep, voffB);
            PG8_WAIT_V(6); PG8_BAR; PG8_MMA(1, 1, At, B1); PG8_BAR;
            PG8_LDB(B0, 1, 0); PG8_SCHED; PG8_LDA(At, 1, 0); PG8_STAGE(PG8_SA(0, 1), a2 + hstep, voffA);
            PG8_WAIT_L(8); PG8_BAR; PG8_WAIT_L(0); PG8_MMA(0, 0, At, B0); PG8_BAR; PG8_SCHED;
            PG8_LDB(B1, 1, 1); PG8_STAGE(PG8_SB(1, 0), b3, voffB);
            PG8_BAR; PG8_WAIT_L(0); PG8_MMA(0, 1, At, B1); PG8_BAR;
            PG8_LDA(At, 1, 1); PG8_STAGE(PG8_SA(1, 0), a3, voffA);
            PG8_BAR; PG8_WAIT_L(0); PG8_MMA(1, 0, At, B0); PG8_BAR; PG8_SCHED;
            PG8_STAGE(PG8_SB(1, 1), b3 + hstep, voffB);
            PG8_WAIT_V(6); PG8_BAR; PG8_MMA(1, 1, At, B1); PG8_BAR;
            }
        }
        if constexpr (ALIGN_EPI) { if (wr == 0) PG8_BAR; }
        if constexpr (!Epi::AFTER_DRAIN) { E(acc, cur, wr, wc, fr, fq); S.done(cur); }
        if (!has_next) break;
#pragma unroll
        for (int a = 0; a < 2; ++a)
#pragma unroll
            for (int b = 0; b < 2; ++b)
#pragma unroll
                for (int m = 0; m < 4; ++m)
#pragma unroll
                    for (int n = 0; n < 2; ++n) acc[a][b][m][n] = (f32x4){0.f, 0.f, 0.f, 0.f};
        cur = nxt; cA = nA; cB = nB; ++ui;
        if constexpr (ALIGN_EPI) { if (wr == 1) PG8_BAR; }
    }
    PG8_WAIT_V(0);
    if constexpr (!ALIGN_EPI) { if (wr == 0) PG8_BAR; }
    PG8_BAR;
    if constexpr (Epi::AFTER_DRAIN) { E.fused(acc, cur, wr, wc, fr, fq, lds, wid, lane); S.done(cur); }
#undef PG8_SA
#undef PG8_SB
#undef PG8_STAGE
#undef PG8_LDA
#undef PG8_LDB
#undef PG8_MMA
#undef PG8_WAIT_V
#undef PG8_WAIT_L
#undef PG8_BAR
#undef PG8_SCHED
}
}

#ifndef PG8_SP2
#define PG8_SP2 true
#endif
#ifndef PG8_ALIGN
#define PG8_ALIGN true
#endif
#include <hip/hip_bf16.h>
#include <cmath>
namespace attn_body {
using bf16=__hip_bfloat16;
using bf16x8=__attribute__((ext_vector_type(8)))short;
using s16x4=__attribute__((ext_vector_type(4)))short;
using f32x16=__attribute__((ext_vector_type(16)))float;
using u32x4=__attribute__((ext_vector_type(4)))unsigned;
using f32x4v=__attribute__((ext_vector_type(4)))float;
constexpr int BATCH=2,NHEAD=16,SEQ=8192,D=64,DM=NHEAD*D;
constexpr int NW=8,QBLK=32,QB=QBLK*NW,KVBLK=64,NQB=SEQ/QB;
constexpr int ATTN_PITCH=DM, ATTN_UNIT_ROWS=QB;
__device__ __forceinline__ int crow(int r,int hi){return (r&3)+8*(r>>2)+4*hi;}
#define SBAR() __builtin_amdgcn_sched_barrier(0)
__device__ __forceinline__ void cmask(f32x16&p0,f32x16&p1,int jb,int qrel,int hi){
  const float NEG=-INFINITY; int kb=64*jb+4*hi;
  #pragma unroll
  for(int r=0;r<16;++r){int kv=kb+(r&3)+8*(r>>2); if(kv>qrel)p0[r]=NEG; if(kv+32>qrel)p1[r]=NEG;}
}

constexpr int NSLOT=3, SLOTB=8192;
constexpr int LDS_K=0, LDS_V=NSLOT*SLOTB, LDS_WS=2*NSLOT*SLOTB, LDS_OST=LDS_WS+NW*64*4, LDS_BIAS=LDS_OST+NW*4096, LDS_BYTES=LDS_BIAS+SEQ*4+256+1024;
constexpr float C2=0.125f*1.4426950408889634f;
__device__ __forceinline__ void glds16(const void*gsrc,unsigned lds_dst){unsigned keep;
  asm volatile("s_mov_b32 %0, m0\n\ts_mov_b32 m0, %2\n\ts_nop 0\n\tglobal_load_lds_dwordx4 %1, off\n\ts_mov_b32 m0, %0":"=&s"(keep):"v"(gsrc),"s"(lds_dst):"memory");}
__device__ __forceinline__ float max3f(float a,float b,float c){float r;asm("v_max3_f32 %0, %1, %2, %3":"=v"(r):"v"(a),"v"(b),"v"(c));return r;}
__device__ __forceinline__ float max2f(float a,float b){float r;asm("v_max_f32_e32 %0, %1, %2":"=v"(r):"v"(a),"v"(b));return r;}
__device__ __forceinline__ float fadd_s(float a,float b){float r;asm("v_add_f32_e32 %0, %1, %2":"=v"(r):"v"(a),"v"(b));return r;}
__device__ __forceinline__ float fsub_s(float a,float b){float r;asm("v_sub_f32_e32 %0, %1, %2":"=v"(r):"v"(a),"v"(b));return r;}
typedef float f32x2_t __attribute__((ext_vector_type(2))); typedef __bf16 bf16x2_t __attribute__((ext_vector_type(2)));
__device__ __forceinline__ unsigned cvtpk_s(float lo,float hi){f32x2_t v={lo,hi};bf16x2_t b=__builtin_convertvector(v,bf16x2_t);return __builtin_bit_cast(unsigned,b);}
#define WAIT_BAR(N) asm volatile("s_waitcnt vmcnt(" #N ") lgkmcnt(0)\n\ts_barrier":::"memory")
__device__ __forceinline__ float silu2(float x){ return x*__builtin_amdgcn_rcpf(1.0f+__builtin_amdgcn_exp2f(-1.4426950408889634f*x)); }

__device__ __forceinline__ void qkt(f32x16&p0,f32x16&p1,const char*Kslot,const bf16x8*qr,int r32,int hi){
  const char*kb=Kslot+hi*1024+r32*16;
  #pragma unroll
  for(int d0=0;d0<4;++d0){
    const bf16x8 b0=*reinterpret_cast<const bf16x8*>(kb+d0*2048);
    const bf16x8 b1=*reinterpret_cast<const bf16x8*>(kb+d0*2048+512);
    {p0=__builtin_amdgcn_mfma_f32_32x32x16_bf16(b0,qr[d0],p0,0,0,0);p1=__builtin_amdgcn_mfma_f32_32x32x16_bf16(b1,qr[d0],p1,0,0,0);}}
}
typedef __attribute__((address_space(3))) const char* lds_cptr;
typedef short v4i16_t __attribute__((ext_vector_type(4)));
__device__ __forceinline__ void kload8(bf16x8*kf,lds_cptr kp){
  kf[0]=*(const __attribute__((address_space(3))) bf16x8*)(kp);      kf[1]=*(const __attribute__((address_space(3))) bf16x8*)(kp+512);
  kf[2]=*(const __attribute__((address_space(3))) bf16x8*)(kp+2048); kf[3]=*(const __attribute__((address_space(3))) bf16x8*)(kp+2560);
  kf[4]=*(const __attribute__((address_space(3))) bf16x8*)(kp+4096); kf[5]=*(const __attribute__((address_space(3))) bf16x8*)(kp+4608);
  kf[6]=*(const __attribute__((address_space(3))) bf16x8*)(kp+6144); kf[7]=*(const __attribute__((address_space(3))) bf16x8*)(kp+6656);
}
__device__ __forceinline__ void kload2(bf16x8*kf,lds_cptr kp,int j){ kf[2*j]=*(const __attribute__((address_space(3))) bf16x8*)(kp+j*2048); kf[2*j+1]=*(const __attribute__((address_space(3))) bf16x8*)(kp+j*2048+512); }
__device__ __forceinline__ s16x4 vtr(lds_cptr p){ return __builtin_bit_cast(s16x4,__builtin_amdgcn_ds_read_tr16_b64_v4i16((__attribute__((address_space(3))) v4i16_t*)p)); }
__device__ __forceinline__ float rowmax(const f32x16&p0,const f32x16&p1){
  float a=max3f(p0[0],p0[1],p1[0]),b=max3f(p0[2],p0[3],p1[1]);a=max3f(a,p1[2],p1[3]);
  #pragma unroll
  for(int r=4;r<16;r+=4){a=max3f(a,p0[r],p0[r+1]);b=max3f(b,p0[r+2],p0[r+3]);a=max3f(a,p1[r],p1[r+1]);b=max3f(b,p1[r+2],p1[r+3]);}
  const float m=max2f(a,b);
  auto rr=__builtin_amdgcn_permlane32_swap(__float_as_uint(m),__float_as_uint(m),false,false);
  return max2f(__uint_as_float(rr[0]),__uint_as_float(rr[1]));
}
__device__ __forceinline__ void pv(f32x16*o,int vb,bf16x8 pa0,bf16x8 pa1,bf16x8 pa2,bf16x8 pa3){
  #pragma unroll
  for(int d0=0;d0<2;++d0){s16x4 lo[4],hi[4];
    #pragma unroll
    for(int ks=0;ks<4;++ks){
      asm volatile("ds_read_b64_tr_b16 %0,%1 offset:%c2":"=&v"(lo[ks]):"v"(vb),"i"(d0*4096+ks*1024):"memory");
      asm volatile("ds_read_b64_tr_b16 %0,%1 offset:%c2":"=&v"(hi[ks]):"v"(vb),"i"(d0*4096+ks*1024+512):"memory");}
    asm volatile("s_waitcnt lgkmcnt(0)":::"memory");SBAR();
    #define PK(k) (bf16x8){lo[k][0],lo[k][1],lo[k][2],lo[k][3],hi[k][0],hi[k][1],hi[k][2],hi[k][3]}
    o[d0]=__builtin_amdgcn_mfma_f32_32x32x16_bf16(pa0,PK(0),o[d0],0,0,0);
    o[d0]=__builtin_amdgcn_mfma_f32_32x32x16_bf16(pa1,PK(1),o[d0],0,0,0);
    o[d0]=__builtin_amdgcn_mfma_f32_32x32x16_bf16(pa2,PK(2),o[d0],0,0,0);
    o[d0]=__builtin_amdgcn_mfma_f32_32x32x16_bf16(pa3,PK(3),o[d0],0,0,0);
    #undef PK
  }
}

#ifndef ATTN_STORE16
#define ATTN_STORE16(p,v) (*(u32x4*)(p)=(v))
#endif
template<int THRL> __device__ __forceinline__ void attn_unit(int b,int h,int qb,const bf16*Q,const bf16*__restrict__ K,const bf16*__restrict__ V,bf16*O,const float*__restrict__ cum,const unsigned*__restrict__ kn,const bf16*__restrict__ Gp,const float*__restrict__ ggrp,float*__restrict__ ssq,char*shm){
  int tid_o=threadIdx.x; asm volatile("":"+v"(tid_o)); const int tid=tid_o,lane=tid&63,r32=lane&31,hi=lane>>5; const int wid=__builtin_amdgcn_readfirstlane(tid>>6);
  const long rowbase=(long)b*SEQ; const int q0=qb*QB;
  const bf16*Qw=Q+(rowbase+q0+wid*QBLK)*DM+h*D;
  const unsigned lds0=(unsigned)(uintptr_t)shm;
  float*wsf=(float*)(shm+LDS_WS)+wid*64;
  int NT=(q0+QB)/KVBLK;
  typedef __attribute__((address_space(3))) float lds_f; typedef __attribute__((address_space(3))) f32x4v lds_f4;
  lds_f* const blp=(lds_f*)((__attribute__((address_space(3))) char*)shm+LDS_BIAS);
  lds_f* const knl=blp+SEQ+64;
  { int z_=0; asm volatile("":"+v"(z_)); const float cref=cum[q0+z_]; const int n4=(q0+QB)>>2;
    for(int i=tid;i<n4;i+=NW*64){ f32x4v v=*reinterpret_cast<const f32x4v*>(cum+4*i); v=cref-v; *(lds_f4*)(blp+4*i)=v; }
    if(tid<NT) knl[tid]=__builtin_sqrtf(__uint_as_float(kn[2*tid])+__uint_as_float(kn[2*tid+1])); }
  bf16x8 qr[4];
  #pragma unroll
  for(int d0=0;d0<4;++d0)qr[d0]=*reinterpret_cast<const bf16x8*>(&Qw[(long)r32*DM+d0*16+hi*8]);
  { float qs=0.f;
    #pragma unroll
    for(int d0=0;d0<4;++d0)
      #pragma unroll
      for(int j=0;j<8;++j){ const float v=__uint_as_float(((unsigned)(unsigned short)qr[d0][j])<<16); qs+=v*v; }
    { auto rr=__builtin_amdgcn_permlane32_swap(__float_as_uint(qs),__float_as_uint(qs),false,false); qs=__uint_as_float(rr[0])+__uint_as_float(rr[1]); }
    #pragma unroll
    for(int o_=1;o_<32;o_<<=1) qs=__builtin_fmaxf(qs,__shfl_xor(qs,o_));
    if(lane==0) knl[128+wid]=qs; }
  asm volatile("s_waitcnt vmcnt(0) lgkmcnt(0)\n\ts_barrier":::"memory");
  int t_start;
  { float q2=knl[128];
    #pragma unroll
    for(int w_=1;w_<NW;++w_) q2=__builtin_fmaxf(q2,knl[128+w_]);
    const float qm=1.03f*__builtin_sqrtf(q2);
    const float ksel=__builtin_fmaxf(__builtin_fmaxf(knl[NT-4],knl[NT-3]),__builtin_fmaxf(knl[NT-2],knl[NT-1]));
    const int t0_=lane,t1_=lane+64;
    const bool ok0=(t0_<NT-4)&&(blp[64*t0_+63]+qm*(knl[t0_]+ksel)<=-152.f);
    const bool ok1=(t1_<NT-4)&&(blp[64*t1_+63]+qm*(knl[t1_]+ksel)<=-152.f);
    const unsigned long long m0=~__ballot(ok0),m1=~__ballot(ok1);
    const int f0=m0?__builtin_ctzll(m0):64,f1=m1?__builtin_ctzll(m1):64;
    t_start=(f0<64)?f0:64+f1; t_start=(t_start>NT-4)?NT-4:t_start; t_start&=~1; t_start=__builtin_amdgcn_readfirstlane(t_start); }
  NT-=t_start;
  const bf16*Kh=K+(rowbase+(long)t_start*KVBLK)*DM+h*D,*Vh=V+(rowbase+(long)t_start*KVBLK)*DM+h*D;
  const bf16*ksrc=Kh+(long)lane*DM+wid*8;
  const bf16*vsrc=Vh+(long)(16*(wid&3)+(lane>>2))*DM+(wid>>2)*32+(lane&3)*8;
  const unsigned kdst=lds0+LDS_K+wid*1024, vdst=lds0+LDS_V+wid*1024;
  #define DMA_K(t,slot) glds16(ksrc+(long)(t)*KVBLK*DM,(unsigned)__builtin_amdgcn_readfirstlane(kdst+(slot)))
  #define DMA_V(t,slot) glds16(vsrc+(long)(t)*KVBLK*DM,(unsigned)__builtin_amdgcn_readfirstlane(vdst+(slot)))
  const int vb0=(int)(lds0+LDS_V)+((lane>>4)&1)*32+(lane&3)*8+(4*hi+((lane&15)>>2))*64;
  const char*Kbase=shm+LDS_K; bf16x8 kf[8];
  const lds_cptr shm3=(lds_cptr)shm; const lds_cptr kp0=shm3+LDS_K+hi*1024+r32*16; const lds_cptr vp0=shm3+LDS_V+((lane>>4)&1)*32+(lane&3)*8+(4*hi+((lane&15)>>2))*64;
  const lds_f* const bq0=blp+4*hi+t_start*KVBLK;
  DMA_K(0,0);DMA_V(0,0);DMA_K(1,SLOTB);
  float mhat=blp[q0+wid*QBLK+r32],l_reg=0.f;f32x16 o[2];o[0]=f32x16{};o[1]=f32x16{};
  const int qrel=wid*QBLK+r32;
  #define CMASK(P0,P1,t) do{int jb_=(t)-(NT-4); if(jb_>=0)cmask(P0,P1,jb_,qrel,hi);}while(0)
  bool resc=false;
  #define BINIT(P0,P1,t) do{ const lds_f* b_=bq0+(t)*KVBLK; _Pragma("unroll") for(int i_=0;i_<4;++i_){ const f32x4v x0_=*(const lds_f4*)(b_+8*i_), x1_=*(const lds_f4*)(b_+32+8*i_); \
      _Pragma("unroll") for(int k_=0;k_<4;++k_){ P0[4*i_+k_]=x0_[k_]-mhat; P1[4*i_+k_]=x1_[k_]-mhat; } } }while(0)
  #define START(P0,P1) do{ const float rm=rowmax(P0,P1); resc=false; \
    { const float dl=__builtin_fmaxf(rm,0.f); mhat=fadd_s(mhat,dl); \
      _Pragma("unroll") for(int r=0;r<16;++r){P0[r]=fsub_s(P0[r],dl);P1[r]=fsub_s(P1[r],dl);} \
      } \
    _Pragma("unroll") for(int r=0;r<16;++r)P0[r]=__builtin_amdgcn_exp2f(P0[r]); }while(0)
  #define RESC() do{ if(resc){ asm volatile("s_waitcnt lgkmcnt(0)":::"memory"); \
      _Pragma("unroll") for(int d_=0;d_<2;++d_) _Pragma("unroll") for(int r=0;r<16;++r)o[d_][r]*=wsf[crow(r,hi)]; } }while(0)
  f32x16 pA0,pA1,pB0,pB1;
  int sl_prev=0,sl_cur=0,sl_next=SLOTB;
  #define ROT() do{sl_prev=sl_cur;sl_cur=sl_next;sl_next=(sl_next==(NSLOT-1)*SLOTB)?0:sl_next+SLOTB;}while(0)
  DMA_K(2,2*SLOTB);
  WAIT_BAR(3);
  BINIT(pA0,pA1,0);
  qkt(pA0,pA1,Kbase,qr,r32,hi);asm volatile("s_nop 15\n\ts_nop 7":"+v"(pA0),"+v"(pA1));CMASK(pA0,pA1,0);
  START(pA0,pA1);
  _Pragma("unroll") for(int r=0;r<16;++r)pA1[r]=__builtin_amdgcn_exp2f(pA1[r]);
  BINIT(pB0,pB1,1);
  WAIT_BAR(0);
  DMA_K(3,0);DMA_V(1,SLOTB);
  ROT();
  kload8(kf,kp0+sl_cur);
  WAIT_BAR(2);
  s16x4 vlo[8],vhi[8]; u32x4 pw0,pw1,pw2,pw3;
  #define PKW(P,B) cvtpk_s(P[B],P[B+1])
  #define PAF(k) __builtin_bit_cast(bf16x8,pw##k)
  #define VFR(i) (bf16x8){vlo[i][0],vlo[i][1],vlo[i][2],vlo[i][3],vhi[i][0],vhi[i][1],vhi[i][2],vhi[i][3]}
  #define PIN(x) asm volatile("":"+v"(x))
  #define MX3(a,b,c) __builtin_fmaxf(__builtin_fmaxf((a),(b)),(c))
  #define GAPA(MF,A0,A1,A2,A3,W0,W1,PW) do{ MF; sacc+=A0; sacc+=A1; sacc+=A2; sacc+=A3; PIN(sacc); W0; W1; PIN(PW); SBAR(); }while(0)
  #define EX(v) __builtin_amdgcn_exp2f(v)
  #define GAPB(MF,X,B,XTRA) do{ MF; X[B]=EX(X[B]); X[B+1]=EX(X[B+1]); X[B+2]=EX(X[B+2]); X[B+3]=EX(X[B+3]); PIN(X); XTRA; SBAR(); }while(0)
  #define BLD(dst,off) dst=*(const lds_f4*)(bqn_+(off))
  #define BSB(P,i,src) do{ P[4*(i)]=src[0]-mhat; P[4*(i)+1]=src[1]-mhat; P[4*(i)+2]=src[2]-mhat; P[4*(i)+3]=src[3]-mhat; PIN(P); }while(0)
  #define VRD(i) do{ vlo[i]=vtr(vp_+(((i)>>2)*4096+((i)&3)*1024)); vhi[i]=vtr(vp_+(((i)>>2)*4096+((i)&3)*1024+512)); }while(0)
  #define KRD(G,j) do{ if(G){ kload2(kf,kp0+sl_next,j); SBAR(); } }while(0)
  #define STEP(C0,C1,P0,P1,t,GK,GV,GL) do{ SBAR(); \
    const lds_cptr vp_=vp0+sl_prev; const lds_f* const bqn_=bq0+((t)+1)*KVBLK; f32x4v bta_,btb_,btc_; \
    VRD(0); SBAR(); float sacc=(P0[0]+P0[1]); \
    GAPA(C0=__builtin_amdgcn_mfma_f32_32x32x16_bf16(kf[0],qr[0],C0,0,0,0), P0[2],P0[3],P0[4],P0[5],     pw0[0]=PKW(P0,0), pw0[1]=PKW(P0,2), pw0); \
    VRD(4); SBAR(); GAPA(C1=__builtin_amdgcn_mfma_f32_32x32x16_bf16(kf[1],qr[0],C1,0,0,0), P0[6],P0[7],P0[8],P0[9],     pw0[2]=PKW(P0,4), pw0[3]=PKW(P0,6), pw0); \
    VRD(1); SBAR(); GAPA(C0=__builtin_amdgcn_mfma_f32_32x32x16_bf16(kf[2],qr[1],C0,0,0,0),   P0[10],P0[11],P0[12],P0[13], pw1[0]=PKW(P0,8), pw1[1]=PKW(P0,10), pw1); \
    VRD(5); SBAR(); GAPA(C1=__builtin_amdgcn_mfma_f32_32x32x16_bf16(kf[3],qr[1],C1,0,0,0),   P0[14],P0[15],P1[0],P1[1],   pw1[2]=PKW(P0,12),pw1[3]=PKW(P0,14), pw1); \
    VRD(2); SBAR(); GAPA(C0=__builtin_amdgcn_mfma_f32_32x32x16_bf16(kf[4],qr[2],C0,0,0,0),   P1[2],P1[3],P1[4],P1[5],     pw2[0]=PKW(P1,0), pw2[1]=PKW(P1,2), pw2); \
    VRD(6); SBAR(); GAPA(C1=__builtin_amdgcn_mfma_f32_32x32x16_bf16(kf[5],qr[2],C1,0,0,0),   P1[6],P1[7],P1[8],P1[9],     pw2[2]=PKW(P1,4), pw2[3]=PKW(P1,6), pw2); \
    VRD(3); SBAR(); GAPA(C0=__builtin_amdgcn_mfma_f32_32x32x16_bf16(kf[6],qr[3],C0,0,0,0),   P1[10],P1[11],P1[12],P1[13], pw3[0]=PKW(P1,8), pw3[1]=PKW(P1,10), pw3); \
    VRD(7); SBAR(); GAPA(C1=__builtin_amdgcn_mfma_f32_32x32x16_bf16(kf[7],qr[3],C1,0,0,0),   P1[14],P1[15],0.f,0.f,       pw3[2]=PKW(P1,12),pw3[3]=PKW(P1,14), pw3); \
    l_reg+=sacc; \
    if(GK){DMA_K((t)+3,sl_cur);} if(GV){DMA_V((t)+1,sl_next);} \
    CMASK(C0,C1,t); \
    { float a=MX3(C0[0],C0[1],C1[0]),b=MX3(C0[2],C0[3],C1[1]); a=MX3(a,C1[2],C1[3]); \
      _Pragma("unroll") for(int r=4;r<16;r+=4){a=MX3(a,C0[r],C0[r+1]);b=MX3(b,C0[r+2],C0[r+3]);a=MX3(a,C1[r],C1[r+1]);b=MX3(b,C1[r+2],C1[r+3]);} \
      float rm=__builtin_fmaxf(a,b); { auto rr=__builtin_amdgcn_permlane32_swap(__float_as_uint(rm),__float_as_uint(rm),false,false); rm=__builtin_fmaxf(__uint_as_float(rr[0]),__uint_as_float(rr[1])); } \
      resc=false; \
      if(__builtin_expect(__any(rm>(float)THRL),0)){ const float dl=__builtin_fmaxf(rm,0.f); mhat+=dl; \
        _Pragma("unroll") for(int r=0;r<16;++r){C0[r]-=dl;C1[r]-=dl;} \
        const float f=__builtin_amdgcn_exp2f(-dl); l_reg*=f; if(hi==0)wsf[r32]=f; resc=true; } } \
    SBAR(); \
    GAPB(o[0]=__builtin_amdgcn_mfma_f32_32x32x16_bf16(PAF(0),VFR(0),o[0],0,0,0), C0,0, BLD(bta_,0)); \
    GAPB(o[1]=__builtin_amdgcn_mfma_f32_32x32x16_bf16(PAF(0),VFR(4),o[1],0,0,0), C0,4, BLD(btb_,8)); \
    KRD(GL,0); GAPB(o[0]=__builtin_amdgcn_mfma_f32_32x32x16_bf16(PAF(1),VFR(1),o[0],0,0,0), C0,8, BLD(btc_,16);BSB(P0,0,bta_)); \
    KRD(GL,1); GAPB(o[1]=__builtin_amdgcn_mfma_f32_32x32x16_bf16(PAF(1),VFR(5),o[1],0,0,0), C0,12, BLD(bta_,24);BSB(P0,1,btb_)); \
    KRD(GL,2); GAPB(o[0]=__builtin_amdgcn_mfma_f32_32x32x16_bf16(PAF(2),VFR(2),o[0],0,0,0), C1,0, BLD(btb_,32);BSB(P0,2,btc_)); \
    KRD(GL,3); GAPB(o[1]=__builtin_amdgcn_mfma_f32_32x32x16_bf16(PAF(2),VFR(6),o[1],0,0,0), C1,4, BLD(btc_,40);BSB(P0,3,bta_)); \
    GAPB(o[0]=__builtin_amdgcn_mfma_f32_32x32x16_bf16(PAF(3),VFR(3),o[0],0,0,0), C1,8, BLD(bta_,48);BSB(P1,0,btb_)); \
    GAPB(o[1]=__builtin_amdgcn_mfma_f32_32x32x16_bf16(PAF(3),VFR(7),o[1],0,0,0), C1,12, BLD(btb_,56);BSB(P1,1,btc_)); \
    BSB(P1,2,bta_); BSB(P1,3,btb_); \
    }while(0)
  int t=1;
  #undef CMASK
  #define CMASK(P0,P1,t) do{}while(0)
  for(;t+5<NT;t+=2){
    STEP(pB0,pB1,pA0,pA1,t,true,true,true);     WAIT_BAR(2); RESC(); ROT();
    STEP(pA0,pA1,pB0,pB1,t+1,true,true,true);   WAIT_BAR(2); RESC(); ROT();
  }
  #undef CMASK
  #define CMASK(P0,P1,t) do{int jb_=(t)-(NT-4); if(jb_>=0)cmask(P0,P1,jb_,qrel,hi);}while(0)
  #define ENDW(tt) do{ if((tt)+3<NT){WAIT_BAR(2);} else if((tt)+2<NT){WAIT_BAR(1);} else {WAIT_BAR(0);} }while(0)
  for(;t+1<NT;t+=2){
    STEP(pB0,pB1,pA0,pA1,t,(t+3<NT),(t+1<NT),(t+1<NT));       ENDW(t);   RESC(); ROT();
    STEP(pA0,pA1,pB0,pB1,t+1,(t+4<NT),(t+2<NT),(t+2<NT));     ENDW(t+1); RESC(); ROT();
  }
  STEP(pB0,pB1,pA0,pA1,NT-1,false,false,false); RESC();
  { float sacc=pB0[0]+pB0[1]; _Pragma("unroll") for(int r=2;r<16;++r)sacc+=pB0[r]; _Pragma("unroll") for(int r=0;r<16;++r)sacc+=pB1[r]; l_reg+=sacc;
    pw0=(u32x4){PKW(pB0,0),PKW(pB0,2),PKW(pB0,4),PKW(pB0,6)};pw1=(u32x4){PKW(pB0,8),PKW(pB0,10),PKW(pB0,12),PKW(pB0,14)};pw2=(u32x4){PKW(pB1,0),PKW(pB1,2),PKW(pB1,4),PKW(pB1,6)};pw3=(u32x4){PKW(pB1,8),PKW(pB1,10),PKW(pB1,12),PKW(pB1,14)};
    SBAR(); pv(o,vb0+sl_cur,PAF(0),PAF(1),PAF(2),PAF(3)); }
  #undef PKW
  #undef PAF
  #undef VFR
  #undef PIN
  #undef MX3
  #undef GAPA
  #undef GAPB
  #undef BLD
  #undef BSB
  #undef BINIT
  #undef EX
  #undef VRD
  #undef KRD
  #undef STEP
  #undef ENDW
  {auto rr=__builtin_amdgcn_permlane32_swap(__float_as_uint(l_reg),__float_as_uint(l_reg),false,false);l_reg=__uint_as_float(rr[0])+__uint_as_float(rr[1]);}
  if(hi==0)wsf[32+r32]=l_reg;asm volatile("s_waitcnt lgkmcnt(0)":::"memory");
  float rli[16];
  #pragma unroll
  for(int r=0;r<16;++r)rli[r]=__builtin_amdgcn_rcpf(wsf[32+crow(r,hi)]);
  bf16*Ow=O+(rowbase+q0+wid*QBLK)*DM+h*D;
  { bf16*stg=(bf16*)(shm+LDS_OST)+wid*2048;
    #pragma unroll
    for(int r=0;r<16;++r){const int orow=crow(r,hi);
      #pragma unroll
      for(int d0=0;d0<2;++d0)stg[orow*64+d0*32+r32]=__float2bfloat16(o[d0][r]*rli[r]);}
    asm volatile("s_waitcnt lgkmcnt(0)":::"memory");
    const int ch=lane&7; const bf16*Gw=Gp+(rowbase+q0+wid*QBLK)*DM+h*D;
    const f32x4v ga=*reinterpret_cast<const f32x4v*>(ggrp+h*D+ch*8),gb=*reinterpret_cast<const f32x4v*>(ggrp+h*D+ch*8+4);
    const float gg[8]={ga[0],ga[1],ga[2],ga[3],gb[0],gb[1],gb[2],gb[3]};
    #pragma unroll
    for(int i=0;i<4;++i){const int row=i*8+(lane>>3); const u32x4 v=*(const u32x4*)(stg+row*64+ch*8); const u32x4 gv=*reinterpret_cast<const u32x4*>(Gw+(long)row*DM+ch*8);
      float s=0.f; u32x4 y;
      #pragma unroll
      for(int k=0;k<4;++k){ const float a0=__uint_as_float(v[k]<<16),a1=__uint_as_float(v[k]&0xffff0000u),g0=__uint_as_float(gv[k]<<16),g1=__uint_as_float(gv[k]&0xffff0000u);
        s+=a0*a0+a1*a1; y[k]=cvtpk_s(a0*gg[2*k]*silu2(g0),a1*gg[2*k+1]*silu2(g1)); }
      s+=__shfl_xor(s,1); s+=__shfl_xor(s,2); s+=__shfl_xor(s,4);
      if(ch==0)ssq[(rowbase+q0+wid*QBLK+row)*16+h]=s;
      ATTN_STORE16(Ow+(long)row*DM+ch*8,y);} }
  asm volatile("s_waitcnt lgkmcnt(0)\n\ts_barrier":::"memory");
  #undef DMA_K
  #undef DMA_V
  #undef CMASK
  #undef START
  #undef RESC
  #undef ROT
}
constexpr int ATTN_LDS_BYTES=LDS_BYTES;
constexpr float SB_EXIT=150.f;
__device__ __forceinline__ void sb_unit(int b,int h,int qb,const bf16*Q,const bf16*__restrict__ K,const bf16*__restrict__ VT,bf16*O,const bf16*__restrict__ Gp,const float*__restrict__ ggrp,float*__restrict__ ssq){
  int tid_o=threadIdx.x; asm volatile("":"+v"(tid_o)); const int tid=tid_o,lane=tid&63,r32=lane&31,hi=lane>>5; const int wid=__builtin_amdgcn_readfirstlane(tid>>6);
  const long rowbase=(long)b*SEQ; const int q0=qb*QB+wid*QBLK;
  const bf16*Qw=Q+(rowbase+q0)*DM+h*D;
  const int pi=16*((r32>>2)&1)+(r32&3)+4*(r32>>3);
  const bf16*Kl=K+(rowbase+pi)*DM+h*D+hi*8;
  const bf16*Vl=VT+((long)((b*8+h)*64+r32))*SEQ+16*hi;
  bf16x8 qr[4];
  #pragma unroll
  for(int d0=0;d0<4;++d0)qr[d0]=*reinterpret_cast<const bf16x8*>(&Qw[(long)r32*DM+d0*16+hi*8]);
  f32x16 o0=f32x16{},o1=f32x16{};
  float carry=0.f; const int qabs=q0+r32; const int ktd=q0>>5;
  bf16x8 kc[4],vc[4],kx[4],vx[4];
  #define SB_LOAD(KF,VF,kt_) do{ const bf16*kp_=Kl+(long)(kt_)*32*DM; const bf16*vp_=Vl+(kt_)*32; \
    _Pragma("unroll") for(int d0=0;d0<4;++d0)KF[d0]=*reinterpret_cast<const bf16x8*>(kp_+16*d0); \
    VF[0]=*reinterpret_cast<const bf16x8*>(vp_); VF[1]=*reinterpret_cast<const bf16x8*>(vp_+8); VF[2]=*reinterpret_cast<const bf16x8*>(vp_+32*SEQ); VF[3]=*reinterpret_cast<const bf16x8*>(vp_+32*SEQ+8); }while(0)
  SB_LOAD(kc,vc,ktd);
  for(int kt=ktd;kt>=0;--kt){
    const int kbase=kt*32;
    { const int ktn=kt>0?kt-1:0; SB_LOAD(kx,vx,ktn); }
    f32x16 p=f32x16{};
    p=__builtin_amdgcn_mfma_f32_32x32x16_bf16(kc[0],qr[0],p,0,0,0);p=__builtin_amdgcn_mfma_f32_32x32x16_bf16(kc[1],qr[1],p,0,0,0);
    p=__builtin_amdgcn_mfma_f32_32x32x16_bf16(kc[2],qr[2],p,0,0,0);p=__builtin_amdgcn_mfma_f32_32x32x16_bf16(kc[3],qr[3],p,0,0,0);
    const bool diag=(kt==ktd); const int key0=kbase+16*hi;
    float l2[16];
    #pragma unroll
    for(int r=0;r<16;++r){ const float t=p[r]; float l=__builtin_amdgcn_logf(1.0f+__builtin_amdgcn_exp2f(t)); l=(t>30.f)?t:l;
      if(diag){ if(key0+r>=qabs)l=0.f; } l2[r]=l; }
    float g[4];
    #pragma unroll
    for(int i=0;i<4;++i)g[i]=(l2[4*i]+l2[4*i+1])+(l2[4*i+2]+l2[4*i+3]);
    const float tot=(g[0]+g[1])+(g[2]+g[3]);
    float pt; { auto rr=__builtin_amdgcn_permlane32_swap(__float_as_uint(tot),__float_as_uint(tot),false,false); const unsigned tu=__float_as_uint(tot); pt=__uint_as_float(rr[0]==tu?rr[1]:rr[0]); }
    float suf[4]; suf[3]=carry+(hi?0.f:pt); suf[2]=suf[3]+g[3]; suf[1]=suf[2]+g[2]; suf[0]=suf[1]+g[1];
    carry+=tot+pt;
    float a[16];
    #pragma unroll
    for(int i=0;i<4;++i){ float c=suf[i];
      #pragma unroll
      for(int k=3;k>=0;--k){ const int r=4*i+k; c+=l2[r]; float av=__builtin_amdgcn_exp2f(p[r]-c); if(diag){ if(key0+r>=qabs)av=0.f; } a[r]=av; } }
    u32x4 w0,w1; w0[0]=cvtpk_s(a[0],a[1]);w0[1]=cvtpk_s(a[2],a[3]);w0[2]=cvtpk_s(a[4],a[5]);w0[3]=cvtpk_s(a[6],a[7]);
    w1[0]=cvtpk_s(a[8],a[9]);w1[1]=cvtpk_s(a[10],a[11]);w1[2]=cvtpk_s(a[12],a[13]);w1[3]=cvtpk_s(a[14],a[15]);
    const bf16x8 pa0=__builtin_bit_cast(bf16x8,w0),pa1=__builtin_bit_cast(bf16x8,w1);
    o0=__builtin_amdgcn_mfma_f32_32x32x16_bf16(pa0,vc[0],o0,0,0,0);o1=__builtin_amdgcn_mfma_f32_32x32x16_bf16(pa0,vc[2],o1,0,0,0);
    o0=__builtin_amdgcn_mfma_f32_32x32x16_bf16(pa1,vc[1],o0,0,0,0);o1=__builtin_amdgcn_mfma_f32_32x32x16_bf16(pa1,vc[3],o1,0,0,0);
    if(__all(carry>=SB_EXIT))break;
    #pragma unroll
    for(int d0=0;d0<4;++d0){kc[d0]=kx[d0];vc[d0]=vx[d0];}
  }
  #undef SB_LOAD
  unsigned short*Ow=(unsigned short*)(O+(rowbase+q0)*DM+h*D);
  const unsigned short*Gw=(const unsigned short*)(Gp+(rowbase+q0)*DM+h*D); const float gg0=ggrp[h*D+r32],gg1=ggrp[h*D+32+r32];
  #pragma unroll
  for(int r=0;r<16;++r){ const long ro=(long)crow(r,hi)*DM; const float a0=o0[r],a1=o1[r];
    float s=a0*a0+a1*a1;
    #pragma unroll
    for(int o_=1;o_<32;o_<<=1)s+=__shfl_xor(s,o_);
    if(r32==0)ssq[(rowbase+q0+crow(r,hi))*16+h]=s;
    const float g0=__uint_as_float(((unsigned)Gw[ro+r32])<<16),g1=__uint_as_float(((unsigned)Gw[ro+32+r32])<<16);
    const unsigned w=cvtpk_s(a0*gg0*silu2(g0),a1*gg1*silu2(g1));
    Ow[ro+r32]=(unsigned short)(w&0xffffu); Ow[ro+32+r32]=(unsigned short)(w>>16); }
}
struct AttnTensors { const bf16* Q; const bf16* K; const bf16* V; bf16* O; const float* cum; };

#undef SBAR
#undef WAIT_BAR
}
constexpr int NWAVES = 8;
#ifndef PROBE_DUP
#define PROBE_DUP 0
#endif
#ifndef MK_PER_PHASE
#define MK_PER_PHASE 0
#endif
constexpr int BATCH = 2, T = 8192, D = 1024, DEPTH = 4, NHEADS = 16, HD = 64;
constexpr int M = BATCH * T;
constexpr int D_IN = 4104, NPROJ = 4096;
constexpr float EPS = 1e-6f, LOG2E = 1.4426950408889634f;
constexpr size_t MiB = 1u << 20;
constexpr size_t WS_CTL = 0, CTL_ZERO_BYTES = 256 * 1024;
constexpr size_t WS_BAR = 16 * 1024, WS_QCTR = 32 * 1024, WS_KN = 64 * 1024;
constexpr size_t WS_BAR_UNUSED_ = 0;
constexpr size_t WS_ADA = 512 * 1024;
constexpr size_t WS_LOGF = 1 * MiB;
constexpr size_t WS_CUM = WS_LOGF + 512 * 1024;
constexpr size_t WS_WIN = 2 * MiB;
constexpr size_t WS_WOUT = WS_WIN + (size_t)DEPTH * NPROJ * D * 2;
constexpr size_t WS_XN = 42 * MiB;
constexpr size_t WS_QO = 74 * MiB, WS_K = 106 * MiB, WS_V = 138 * MiB, WS_G = 170 * MiB, WS_O = 202 * MiB, WS_SSQ = 234 * MiB, WS_VT = 235 * MiB, WS_END = 251 * MiB;
static_assert(WS_WOUT + (size_t)DEPTH * D * D * 2 <= WS_XN && WS_XN + (size_t)M * D * 2 <= WS_QO, "d_ws map");
constexpr int RING_BYTES = 131072, LDS_BYTES = 147456, MISC_OFF = RING_BYTES + 320, BARST_OFF = MISC_OFF + 64;
static_assert(attn_body::ATTN_LDS_BYTES <= RING_BYTES, "attention LDS");

#define GAS __attribute__((address_space(1)))
#define LAS __attribute__((address_space(3)))
typedef unsigned short bf16;
typedef unsigned v4u __attribute__((ext_vector_type(4)));
typedef float f32x4 __attribute__((ext_vector_type(4)));
#define LDS_WAIT() asm volatile("s_waitcnt lgkmcnt(0)" ::: "memory")
__device__ __forceinline__ unsigned f2bf(float f) { unsigned u = __builtin_bit_cast(unsigned, f); return (u + 0x7fffu + ((u >> 16) & 1u)) >> 16; }
__device__ __forceinline__ unsigned pk2(float lo, float hi) { return f2bf(lo) | (f2bf(hi) << 16); }
__device__ __forceinline__ float bf_lo(unsigned w) { return __uint_as_float(w << 16); }
__device__ __forceinline__ float bf_hi(unsigned w) { return __uint_as_float(w & 0xffff0000u); }
__device__ __forceinline__ float wave_sum(float v) {
#pragma unroll
    for (int o = 1; o < 64; o <<= 1) v += __shfl_xor(v, o);
    return v;
}
__device__ __forceinline__ void transpose_item(const float* W, int ldw, int k0, int n0, bf16* WT, int ldt, int drow0, LAS float* scr, int lane) {
#pragma unroll 8
    for (int i = 0; i < 32; ++i) { const int kk = 2 * i + (lane >> 5); scr[kk * 33 + (lane & 31)] = W[(size_t)(k0 + kk) * ldw + n0 + (lane & 31)]; }
    LDS_WAIT(); asm volatile("" ::: "memory");
    const int c = lane & 7;
#pragma unroll
    for (int j = 0; j < 4; ++j) { const int n = (lane >> 3) + 8 * j; const LAS float* s = scr + (8 * c) * 33 + n;
        v4u o; o.x = pk2(s[0 * 33], s[1 * 33]); o.y = pk2(s[2 * 33], s[3 * 33]); o.z = pk2(s[4 * 33], s[5 * 33]); o.w = pk2(s[6 * 33], s[7 * 33]);
        *(v4u*)(WT + (size_t)(drow0 + n) * ldt + k0 + 8 * c) = o; }
    LDS_WAIT(); asm volatile("" ::: "memory");
}
__device__ __forceinline__ float silu_f(float x) { return x * __builtin_amdgcn_rcpf(1.0f + __builtin_amdgcn_exp2f(-x * LOG2E)); }

#define XB_TMO      128
#define XB_XCNT(j)  (256  + 64 * (j))
#define XB_XSUB(j)  (1280 + 64 * (j))
#define XB_XGEN(j)  (2304 + 64 * (j))
#define XB_TOP      3328
#define XB_TOPGEN   3392
#define XCD_BAR_WORDS 3456
#define XB_SPIN_CAP (1u << 18)

__device__ __forceinline__ unsigned xb_ld(unsigned* p)              { return __hip_atomic_load(p, __ATOMIC_RELAXED, __HIP_MEMORY_SCOPE_AGENT); }
__device__ __forceinline__ unsigned xb_add(unsigned* p, unsigned v) { return __hip_atomic_fetch_add(p, v, __ATOMIC_RELAXED, __HIP_MEMORY_SCOPE_AGENT); }
__device__ __forceinline__ unsigned xb_xcc_id() { return (unsigned)__builtin_amdgcn_s_getreg((3 << 11) | 20) & 0xFu; }
#define XB_SPIN(cond, bar) do { unsigned _sp = 0; while (cond) { __builtin_amdgcn_s_sleep(1); \
    if ((++_sp & 255u) == 0u) { if (xb_ld(&(bar)[XB_TMO])) break; if (_sp > XB_SPIN_CAP) { atomicAdd(&(bar)[XB_TMO], 1u); break; } } } } while (0)

struct XcdBarrier {
    unsigned* bar; unsigned x;
    volatile LAS unsigned* st;
};

__device__ __forceinline__ XcdBarrier xcd_barrier_post(unsigned* bar, volatile LAS unsigned* st) {
    XcdBarrier b; b.bar = bar; b.x = xb_xcc_id(); b.st = st;
    if (threadIdx.x == 0) (void)xb_add(&bar[XB_XCNT(b.x)], 1u);
    return b;
}
__device__ __forceinline__ void xcd_barrier_complete(unsigned* bar, unsigned x, unsigned& nloc, unsigned& nx) {
    const unsigned G = gridDim.x * gridDim.y * gridDim.z;
    unsigned sum, cnt, mine, sp = 0u;
    for (;;) {
        sum = 0u; cnt = 0u; mine = 0u;
#pragma unroll
        for (unsigned j = 0; j < 16; ++j) { const unsigned c = xb_ld(&bar[XB_XCNT(j)]); sum += c; cnt += (c > 0u) ? 1u : 0u; mine = (j == x) ? c : mine; }
        if (sum == G) break;
        __builtin_amdgcn_s_sleep(1);
        if ((++sp & 255u) == 0u) { if (xb_ld(&bar[XB_TMO])) break; if (sp > XB_SPIN_CAP) { atomicAdd(&bar[XB_TMO], 1u); break; } }
    }
    nloc = mine > 0u ? mine : 1u; nx = cnt > 0u ? cnt : 1u;
}

__device__ __forceinline__ void xcd_barrier(const XcdBarrier& b) {
    asm volatile("s_waitcnt vmcnt(0)" ::: "memory");
    __syncthreads();
    if (threadIdx.x == 0) {
        unsigned* bar = b.bar;
        __builtin_amdgcn_s_waitcnt(0);
        unsigned nloc = b.st[0], nx = b.st[1];
        if (nloc == 0u) { xcd_barrier_complete(bar, b.x, nloc, nx); b.st[0] = nloc; b.st[1] = nx; }
        const unsigned old = xb_add(&bar[XB_XSUB(b.x)], 1u);
        const unsigned gen = old / nloc;
        if (old + 1u == (gen + 1u) * nloc) {
            __builtin_amdgcn_fence(__ATOMIC_RELEASE, "agent");
            asm volatile("s_waitcnt vmcnt(0)" ::: "memory");
            const unsigned og = xb_add(&bar[XB_TOP], 1u);
            const unsigned tg = og / nx;
            if (og + 1u == (tg + 1u) * nx) xb_add(&bar[XB_TOPGEN], 1u);
            else XB_SPIN(xb_ld(&bar[XB_TOPGEN]) == tg, bar);
            __builtin_amdgcn_fence(__ATOMIC_ACQUIRE, "agent");
            xb_add(&bar[XB_XGEN(b.x)], 1u);
            asm volatile("s_waitcnt vmcnt(0)" ::: "memory");
        } else {
            XB_SPIN(xb_ld(&bar[XB_XGEN(b.x)]) == gen, bar);
            __builtin_amdgcn_fence(__ATOMIC_ACQUIRE, "agent");
            asm volatile("s_waitcnt vmcnt(0)" ::: "memory");
        }
    }
    __syncthreads();
}

struct Args { const float* in[10]; float* out; unsigned char* ws; int ph_lo, ph_hi; };
constexpr int N_PHASES = 2 + 4 * DEPTH;

__global__ void __launch_bounds__(NWAVES * 64, 2) hyb_fwd(Args args) {
    extern __shared__ __attribute__((aligned(16))) unsigned char lds[];
    LAS unsigned char* const L = (LAS unsigned char*)lds;
#define PHASE_IDS() int tid_o = threadIdx.x; asm volatile("" : "+v"(tid_o)); const int tid = tid_o, lane = tid & 63, wave = __builtin_amdgcn_readfirstlane(tid >> 6); const int gw = vcu * NWAVES + wave; (void)tid; (void)lane; (void)gw
    const int G = gridDim.x; const int bx = blockIdx.x; const int vcu = (G % 8 == 0) ? (bx % 8) * (G / 8) + bx / 8 : bx;
    const int NGW = G * NWAVES;
    unsigned char* const ws = args.ws;
    const float* x_in = args.in[0]; const float* c_in = args.in[1]; const float* w_ada = args.in[2]; const float* b_ada = args.in[3]; const float* g_norm = args.in[4];
    const float* w_in = args.in[5]; const float* b_f = args.in[6]; const float* g_grp = args.in[7]; const float* w_out = args.in[8]; const float* g_final = args.in[9];
    float* const out = args.out;
    float* const ADA = (float*)(ws + WS_ADA); float* const LOGF = (float*)(ws + WS_LOGF); float* const CUM = (float*)(ws + WS_CUM);
    bf16* const WIN = (bf16*)(ws + WS_WIN); bf16* const WOUT = (bf16*)(ws + WS_WOUT); bf16* const XN = (bf16*)(ws + WS_XN);
    bf16* const QO = (bf16*)(ws + WS_QO); bf16* const KB = (bf16*)(ws + WS_K); bf16* const VB = (bf16*)(ws + WS_V); bf16* const GB = (bf16*)(ws + WS_G); bf16* const OB = (bf16*)(ws + WS_O); unsigned* const KN = (unsigned*)(ws + WS_KN); unsigned* const QCTR = (unsigned*)(ws + WS_QCTR); float* const SSQ = (float*)(ws + WS_SSQ); bf16* const VT = (bf16*)(ws + WS_VT);
    const int lo = args.ph_lo, hi_ph = args.ph_hi;
    cg::grid_group grid = cg::this_grid();
    for (int u = threadIdx.x; u < (LDS_BYTES - RING_BYTES) / 4; u += NWAVES * 64) ((LAS unsigned*)(L + RING_BYTES))[u] = 0u;
    __syncthreads();
    XcdBarrier bar = xcd_barrier_post((unsigned*)(ws + WS_BAR), (volatile LAS unsigned*)(L + BARST_OFF));
    if (lo < 0) grid.sync();
#define IN(k) (lo <= (k) && (k) < hi_ph)
#define SEAM(k) do { if (IN(k) && IN((k) + 1)) xcd_barrier(bar); } while (0)

    if (IN(0)) { PHASE_IDS();
        LAS float* scr = (LAS float*)(L + wave * 16384);
        constexpr int I_IN = (D / 64) * (NPROJ / 32), I_OUT = (D / 64) * (D / 32), I_L = I_IN + I_OUT;
        for (int it = gw; it < DEPTH * I_L; it += NGW) {
            const int l = it / I_L; int r = it % I_L;
            if (r < I_IN) { const int kb = r / (NPROJ / 32), db = r % (NPROJ / 32), seg = db >> 4;
                const int sseg = seg == 1 ? 3 : seg == 2 ? 1 : seg == 3 ? 4 : seg == 4 ? 2 : seg;
                transpose_item(w_in + (size_t)l * D * D_IN, D_IN, 64 * kb, sseg * 512 + (db & 15) * 32, WIN + (size_t)l * NPROJ * D, D, 32 * db, scr, lane); }
            else { r -= I_IN; const int kb = r / (D / 32), db = r % (D / 32);
                transpose_item(w_out + (size_t)l * D * D, D, 64 * kb, 32 * db, WOUT + (size_t)l * D * D, D, 32 * db, scr, lane); }
        }
        if (bx < DEPTH * 48) {
            const int l = bx / 48, cb = bx % 48, cl = tid & 15, kg = tid >> 4;
            const float* wp = w_ada + ((size_t)l * D + kg) * (3 * D) + cb * 64 + 4 * cl;
            f32x4 a0 = (f32x4){0.f, 0.f, 0.f, 0.f}, a1 = a0;
#pragma unroll 8
            for (int i = 0; i < 32; ++i) { const f32x4 w = *(const f32x4*)(wp + (size_t)(32 * i) * (3 * D)); const float c0 = silu_f(c_in[kg + 32 * i]), c1 = silu_f(c_in[D + kg + 32 * i]); a0 += w * c0; a1 += w * c1; }
            LAS f32x4* red = (LAS f32x4*)L;
            __syncthreads();
            red[(kg * 2 + 0) * 16 + cl] = a0; red[(kg * 2 + 1) * 16 + cl] = a1;
            __syncthreads();
            if (tid < 32) { const int b = tid >> 4, c2 = tid & 15; f32x4 s = *(const f32x4*)(b_ada + (size_t)l * 3 * D + cb * 64 + 4 * c2);
                for (int k2 = 0; k2 < 32; ++k2) s += red[(k2 * 2 + b) * 16 + c2];
                *(f32x4*)(ADA + ((size_t)l * 2 + b) * 3 * D + cb * 64 + 4 * c2) = s; }
            __syncthreads();
        }
    }
    SEAM(0);

    for (int l = 0; l < DEPTH; ++l) {
        const int pb = 1 + 4 * l;
        const float* xsrc = (l == 0) ? x_in : out;
        const float* ada = ADA + (size_t)l * 2 * 3 * D;
        if (IN(pb)) { PHASE_IDS();
            const float* wf = w_in + (size_t)l * D * D_IN + NPROJ;
            f32x4 wfa[4][4][2], gv[4];
#pragma unroll
            for (int j = 0; j < 4; ++j) { gv[j] = *(const f32x4*)(g_norm + l * D + 4 * lane + 256 * j);
#pragma unroll
                for (int c = 0; c < 4; ++c) { const float* p = wf + (size_t)(4 * lane + 256 * j + c) * D_IN; wfa[j][c][0] = *(const f32x4*)p; wfa[j][c][1] = *(const f32x4*)(p + 4); } }
            const float bfl = (lane < 8) ? b_f[l * 8 + lane] : 0.f;
            f32x4 v[4];
#pragma unroll
            for (int j = 0; j < 4; ++j) v[j] = *(const f32x4*)(xsrc + (size_t)gw * D + 4 * lane + 256 * j);
            for (int m = gw; m < M; m += NGW) {
                const float* ab = ada + (size_t)(m / T) * 3 * D;
                f32x4 vn[4]; const int mn = (m + NGW < M) ? m + NGW : m;
#pragma unroll
                for (int j = 0; j < 4; ++j) vn[j] = *(const f32x4*)(xsrc + (size_t)mn * D + 4 * lane + 256 * j);
                float ss = 0.f;
#pragma unroll
                for (int j = 0; j < 4; ++j) ss += (v[j].x * v[j].x + v[j].y * v[j].y) + (v[j].z * v[j].z + v[j].w * v[j].w);
                const float rstd = 1.0f / sqrtf(wave_sum(ss) * (1.f / D) + EPS);
                float f[8];
#pragma unroll
                for (int k = 0; k < 8; ++k) f[k] = 0.f;
#pragma unroll
                for (int j = 0; j < 4; ++j) { const f32x4 sh = *(const f32x4*)(ab + 4 * lane + 256 * j), sc = *(const f32x4*)(ab + D + 4 * lane + 256 * j);
                    const f32x4 hh = (v[j] * rstd) * gv[j] * (sc + 1.0f) + sh;
                    *(unsigned long long*)(XN + (size_t)m * D + 4 * lane + 256 * j) = (unsigned long long)pk2(hh.x, hh.y) | ((unsigned long long)pk2(hh.z, hh.w) << 32);
#pragma unroll
                    for (int c = 0; c < 4; ++c) {
#pragma unroll
                        for (int k = 0; k < 4; ++k) { f[k] += hh[c] * wfa[j][c][0][k]; f[4 + k] += hh[c] * wfa[j][c][1][k]; } } }
#pragma unroll
                for (int k = 0; k < 8; ++k) f[k] = wave_sum(f[k]);
                float fv = f[0];
#pragma unroll
                for (int k = 1; k < 8; ++k) fv = (lane == k) ? f[k] : fv;
                if (lane < 8) { const float tt = -(fv + bfl) * LOG2E;
                    const float lf = (tt > 30.f) ? -tt : -__builtin_amdgcn_logf(1.0f + __builtin_amdgcn_exp2f(tt));
                    LOGF[(size_t)m * 8 + lane] = lf; }
#pragma unroll
                for (int j = 0; j < 4; ++j) v[j] = vn[j];
            }
        }
        SEAM(pb);
        if (IN(pb + 1)) {
            if (bx < BATCH * 8) { PHASE_IDS();
                const int b = bx >> 3, h8 = bx & 7; LAS float* wt = (LAS float*)(L + MISC_OFF);
                float pv[16]; float run = 0.f;
#pragma unroll
                for (int i = 0; i < 16; ++i) { run += LOGF[((size_t)b * T + 16 * tid + i) * 8 + h8]; pv[i] = run; }
                float inc = run;
#pragma unroll
                for (int o = 1; o < 64; o <<= 1) { const float t = __shfl_up(inc, o); if (lane >= o) inc += t; }
                if (lane == 63) wt[wave] = inc;
                __syncthreads();
                float off = inc - run;
                for (int w = 0; w < wave; ++w) off += wt[w];
#pragma unroll
                for (int i = 0; i < 16; ++i) CUM[(size_t)bx * T + 16 * tid + i] = off + pv[i];
                __syncthreads();
            }
            pg8::Gemm g{XN, WIN + (size_t)l * NPROJ * D, M, NPROJ, D}; pg8::StaticOrder S; S.init(M, NPROJ, G, bx);
            pg8::EpiBf16<0> E{VT, 2, 512, KN + (size_t)l * 16 * 128 * 2, 1, 512, T, QO, D, nullptr, D, (size_t)(WS_K - WS_QO) / 2, attn_body::C2};
            pg8::gemm_phase<pg8::EpiBf16<0>, pg8::StaticOrder, PG8_ALIGN, PG8_SP2>(L, g, S, E);
        }
        SEAM(pb + 1);
        if (IN(pb + 2)) {
            const attn_body::bf16* Qp = (const attn_body::bf16*)QO; const attn_body::bf16* Kp = (const attn_body::bf16*)KB; const attn_body::bf16* Vp = (const attn_body::bf16*)VB;
            const float* ggl = g_grp + (size_t)l * D;
            volatile LAS unsigned* const qw = (volatile LAS unsigned*)(L + MISC_OFF + 32);
            const int xq0 = bx & 7; bool own = true;
            for (;;) {
                __syncthreads();
                if (threadIdx.x < 64) { const int ln = threadIdx.x; unsigned idx = 0xffffffffu; int qsel = xq0;
                    if (own) { unsigned r = 0u; if (ln == 0) r = atomicAdd(QCTR + (size_t)(l * 8 + xq0) * 64, 1u); r = (unsigned)__builtin_amdgcn_readfirstlane((int)r); if (r < 128u) idx = r; else own = false; }
                    if (!own && idx == 0xffffffffu) {
                        for (;;) {
                            const unsigned c = (ln < 8) ? __hip_atomic_load(QCTR + (size_t)(l * 8 + ln) * 64, __ATOMIC_RELAXED, __HIP_MEMORY_SCOPE_AGENT) : 128u;
                            const unsigned a8 = (unsigned)__ballot(c < 128u) & 0xffu;
                            if (!a8) break;
                            const unsigned rot = ((a8 >> xq0) | (a8 << (8 - xq0))) & 0xffu; const int q = (xq0 + __builtin_ctz(rot)) & 7;
                            unsigned r = 0u; if (ln == 0) r = atomicAdd(QCTR + (size_t)(l * 8 + q) * 64, 1u); r = (unsigned)__builtin_amdgcn_readfirstlane((int)r);
                            if (r < 128u) { idx = r; qsel = q; break; }
                        } }
                    if (ln == 0) { qw[0] = idx; qw[1] = (unsigned)qsel; } }
                __syncthreads();
                const unsigned idx = qw[0]; const int xq = (int)qw[1], qb_ = xq >> 2, pr = xq & 3;
                if (idx >= 128u) break;
                if (idx < 64u) { const int h8 = (idx & 1u) ? pr : 7 - pr, qb = 31 - (int)(idx >> 1), bh = qb_ * 8 + h8;
                    attn_body::attn_unit<8>(qb_, 8 + h8, qb, Qp, Kp, Vp, (attn_body::bf16*)OB, CUM + (size_t)bh * T, KN + ((size_t)l * 16 + bh) * 256, (const attn_body::bf16*)GB, ggl, SSQ, (char*)lds); }
                else { const unsigned j2 = idx - 64u; attn_body::sb_unit(qb_, 2 * pr + (int)(j2 & 1u), 31 - (int)(j2 >> 1), Qp, Kp, (const attn_body::bf16*)VT, (attn_body::bf16*)OB, (const attn_body::bf16*)GB, ggl, SSQ); }
            }
        }
        SEAM(pb + 2);
        if (IN(pb + 3)) {
            pg8::Gemm g{OB, WOUT + (size_t)l * D * D, M, D, D}; pg8::StaticOrder S; S.init(M, D, G, bx);
            pg8::EpiRes E{xsrc, out, D, ada + 2 * D, T, 3 * D, SSQ, EPS};
            pg8::gemm_phase<pg8::EpiRes, pg8::StaticOrder, PG8_ALIGN, PG8_SP2>(L, g, S, E);
        }
        SEAM(pb + 3);
    }
    if (IN(N_PHASES - 1)) { PHASE_IDS();
        f32x4 gv[4];
#pragma unroll
        for (int j = 0; j < 4; ++j) gv[j] = *(const f32x4*)(g_final + 4 * lane + 256 * j);
        for (int m = gw; m < M; m += NGW) {
            f32x4 v[4]; float ss = 0.f;
#pragma unroll
            for (int j = 0; j < 4; ++j) { v[j] = *(const f32x4*)(out + (size_t)m * D + 4 * lane + 256 * j); ss += (v[j].x * v[j].x + v[j].y * v[j].y) + (v[j].z * v[j].z + v[j].w * v[j].w); }
            const float rstd = 1.0f / sqrtf(wave_sum(ss) * (1.f / D) + EPS);
#pragma unroll
            for (int j = 0; j < 4; ++j) *(f32x4*)(out + (size_t)m * D + 4 * lane + 256 * j) = (v[j] * rstd) * gv[j];
        }
    }
#undef IN
#undef SEAM
}

extern "C" void kernel_launch(void* const* d_in, const int* in_sizes, int n_in, void* d_out, int out_size, void* d_ws, size_t ws_size, hipStream_t stream) {
    static int grid = 0;
    if (grid == 0) {
        if (n_in != 10 || in_sizes[0] != M * D || out_size != M * D || ws_size < WS_END) { fprintf(stderr, "kernel_launch: unexpected shapes (n_in %d, in0 %d, out %d, ws %zu)\n", n_in, n_in > 0 ? in_sizes[0] : -1, out_size, ws_size); grid = -1; return; }
        int dev = 0, cus = 0, per_cu = 0;
        if (hipGetDevice(&dev) != hipSuccess || hipDeviceGetAttribute(&cus, hipDeviceAttributeMultiprocessorCount, dev) != hipSuccess) { grid = -1; return; }
        if (hipFuncSetAttribute((const void*)hyb_fwd, hipFuncAttributeMaxDynamicSharedMemorySize, LDS_BYTES) != hipSuccess) { fprintf(stderr, "kernel_launch: hipFuncSetAttribute failed\n"); grid = -1; return; }
        if (hipOccupancyMaxActiveBlocksPerMultiprocessor(&per_cu, (const void*)hyb_fwd, NWAVES * 64, LDS_BYTES) != hipSuccess || per_cu < 1) { fprintf(stderr, "kernel_launch: occupancy query says %d\n", per_cu); per_cu = 1; }
        (void)hipGetLastError();
        grid = cus * 1;
    }
    if (grid < 0) return;
    if (hipMemsetAsync((char*)d_ws + WS_CTL, 0, CTL_ZERO_BYTES, stream) != hipSuccess) { fprintf(stderr, "kernel_launch: memset failed\n"); return; }
    Args a{};
    for (int i = 0; i < 10; ++i) a.in[i] = (const float*)d_in[i];
    a.out = (float*)d_out; a.ws = (unsigned char*)d_ws;
#if MK_PER_PHASE
    for (int p = 0; p < N_PHASES; ++p) { a.ph_lo = p; a.ph_hi = p + 1; void* kargs[] = {&a};
        hipError_t e = hipLaunchCooperativeKernel((const void*)hyb_fwd, dim3(grid), dim3(NWAVES * 64), kargs, LDS_BYTES, stream);
        if (e != hipSuccess) { fprintf(stderr, "kernel_launch: launch of phase %d failed: %s\n", p, hipGetErrorString(e)); break; } }
#else
    a.ph_lo = 0; a.ph_hi = N_PHASES; void* kargs[] = {&a};
    hipError_t e = hipLaunchCooperativeKernel((const void*)hyb_fwd, dim3(grid), dim3(NWAVES * 64), kargs, LDS_BYTES, stream);
    if (e != hipSuccess) fprintf(stderr, "kernel_launch: cooperative launch failed: %s (grid %d)\n", hipGetErrorString(e), grid);
#endif
}
```

```cpp
#include <hip/hip_runtime.h>
#include <hip/hip_cooperative_groups.h>
#include <cstdio>
#include <cstdint>
namespace cg = cooperative_groups;
namespace pg8 {
#define PG8_LAS __attribute__((address_space(3)))
typedef unsigned short bf16_t;
typedef short bf16x8 __attribute__((ext_vector_type(8)));
typedef float f32x4 __attribute__((ext_vector_type(4)));
typedef unsigned u32x4 __attribute__((ext_vector_type(4)));
constexpr int BM = 256, BK = 64, HALF = 128, HTB = HALF * BK * 2  , STAGE_BYTES = 8 * HTB, NXCD = 8, WGM = 8;

__host__ __device__ __forceinline__ int lds_byte(int r, int c) { const int st = (r >> 4) * 2 + (c >> 5), rr = r & 15, cc = c & 31, ob = rr * 64 + cc * 2; return st * 1024 + (ob ^ (((ob >> 9) & 1) << 5)); }
__host__ __device__ __forceinline__ void stage_rc(int b, int& R, int& C) { const int st = b / 1024, sb = b % 1024, swz = sb ^ (((sb >> 9) & 1) << 5); R = (st >> 1) * 16 + swz / 64; C = (st & 1) * 32 + (swz % 64) / 2; }
__host__ __device__ __forceinline__ int perm32(int rho) { const int n = rho >> 4, i = rho & 15; return 8 * (i >> 2) + 4 * n + (i & 3); }

struct Unit { int pm, pn; };
struct Gemm { const bf16_t* A; const bf16_t* Bt; int M, N, K; };

struct StaticOrder {
    int nM, nN, nwg, G, c;
    __host__ __device__ void init(int M, int N, int G_, int c_) { nM = M / BM; nN = N / BM; nwg = nM * nN; G = G_; c = c_; }
    __host__ __device__ bool next(int i, Unit& u) const {
        const long L = (long)i * G + c; if (L >= nwg) return false;
        int wgid = (int)L; { const int q = nwg / NXCD, r = nwg % NXCD, xcd = wgid % NXCD, off = wgid / NXCD; wgid = (xcd < r ? xcd * (q + 1) : r * (q + 1) + (xcd - r) * q) + off; }
        const int nig = WGM * nN, gid = wgid / nig, fm = gid * WGM, gsz = (nM - fm) < WGM ? (nM - fm) : WGM;
        u.pm = fm + ((wgid % nig) % gsz); u.pn = (wgid % nig) / gsz; return true;
    }
    __device__ __forceinline__ void a_ready(const Unit&) const {}
    __device__ __forceinline__ void done(const Unit&) const {}
};

__device__ __forceinline__ unsigned cvt_pk_bf16(float lo, float hi) { unsigned r; asm volatile("v_cvt_pk_bf16_f32 %0, %1, %2" : "=v"(r) : "v"(lo), "v"(hi)); return r; }
typedef float f32x2 __attribute__((ext_vector_type(2)));
__device__ __forceinline__ f32x2 gelu_pk(f32x2 v) {
    const f32x2 av = __builtin_elementwise_abs(v), d = av * 0.2316418882f + 1.0f;
    f32x2 t; t.x = __builtin_amdgcn_rcpf(d.x); t.y = __builtin_amdgcn_rcpf(d.y);
    f32x2 q = t * 0.5307027145f + (-0.7265760135f); q = q * t + 0.7107068705f; q = q * t + (-0.142248368f); q = q * t + 0.127414796f; q = q * t;
    const f32x2 s = (v * v) * (-0.72134752044f);
    f32x2 e; e.x = __builtin_amdgcn_exp2f(s.x); e.y = __builtin_amdgcn_exp2f(s.y);
    const f32x2 m = v * (q * e), r = v - m;
    f32x2 o; o.x = v.x < 0.f ? m.x : r.x; o.y = v.y < 0.f ? m.y : r.y; return o;
}

template <int ACT  > struct EpiBf16 {
    static constexpr bool PERM = true, AFTER_DRAIN = false, MID = false; static_assert(ACT == 0 || ACT == 1, "EpiBf16: ACT is 0 (none) or 1 (gelu_pk)");
    bf16_t* vt; int vt_tile, vt_cols;
    unsigned* kn; int kn_tile, kn_col0, kn_rows;
    bf16_t* O; int ldc; const float* bias; int split_cols; size_t split_stride; float scale0;
    __device__ __forceinline__ void operator()(const f32x4 (&acc)[2][2][4][2], const Unit& u, int wr, int wc, int fr, int fq) const {
        const int row0 = u.pm * BM + wr * 64 + fr; int colt = u.pn * BM; bf16_t* base = O;
        float sc = 1.f; int tsp = 0; if (split_cols) { const int t = colt / split_cols; tsp = t; base += (size_t)t * split_stride; colt -= t * split_cols; if (t == 0) sc = scale0; }
        if (kn && tsp == kn_tile && colt >= kn_col0) {
#pragma unroll
            for (int ai = 0; ai < 2; ++ai)
#pragma unroll
                for (int bj = 0; bj < 2; ++bj) { float mx = 0.f;
#pragma unroll
                    for (int m = 0; m < 4; ++m) { const f32x4 a = acc[ai][bj][m][0], b = acc[ai][bj][m][1]; float s = (a[0] * a[0] + a[1] * a[1]) + (a[2] * a[2] + a[3] * a[3]) + (b[0] * b[0] + b[1] * b[1]) + (b[2] * b[2] + b[3] * b[3]);
                        s += __shfl_xor(s, 16); s += __shfl_xor(s, 32); mx = __builtin_fmaxf(mx, s); }
                    mx = __builtin_fmaxf(mx, __shfl_xor(mx, 1)); mx = __builtin_fmaxf(mx, __shfl_xor(mx, 2)); mx = __builtin_fmaxf(mx, __shfl_xor(mx, 4)); mx = __builtin_fmaxf(mx, __shfl_xor(mx, 8));
                    if (fr == 0 && fq == 0) { const int r0 = u.pm * BM + ai * HALF + wr * 64, bb = r0 / kn_rows, tile = (r0 % kn_rows) >> 6, h8 = (colt - kn_col0 + bj * HALF + wc * 32) >> 6;
                        atomicMax(kn + ((size_t)(bb * 8 + h8) * 128 + tile) * 2 + (wc & 1), __float_as_uint(mx)); } }
        }
        const int col0 = colt + wc * 32 + 8 * fq, bcol0 = u.pn * BM + wc * 32 + 8 * fq;
        f32x4 bv[2][2];
#pragma unroll
        for (int bj = 0; bj < 2; ++bj)
#pragma unroll
            for (int n = 0; n < 2; ++n) bv[bj][n] = bias ? *(const f32x4*)(bias + bcol0 + bj * HALF + 4 * n) : (f32x4){0.f, 0.f, 0.f, 0.f};
#pragma unroll
        for (int ai = 0; ai < 2; ++ai)
#pragma unroll
            for (int m = 0; m < 4; ++m) { bf16_t* rowp = base + (size_t)(row0 + ai * HALF + m * 16) * ldc + col0;
#pragma unroll
                for (int bj = 0; bj < 2; ++bj) { f32x4 v0 = acc[ai][bj][m][0] + bv[bj][0], v1 = acc[ai][bj][m][1] + bv[bj][1];
                    if (ACT == 1) { f32x2 a = gelu_pk((f32x2){v0[0], v0[1]}), b = gelu_pk((f32x2){v0[2], v0[3]}), c = gelu_pk((f32x2){v1[0], v1[1]}), d = gelu_pk((f32x2){v1[2], v1[3]});
                        v0 = (f32x4){a.x, a.y, b.x, b.y}; v1 = (f32x4){c.x, c.y, d.x, d.y}; }
                    v0 = v0 * sc; v1 = v1 * sc; u32x4 w; w.x = cvt_pk_bf16(v0[0], v0[1]); w.y = cvt_pk_bf16(v0[2], v0[3]); w.z = cvt_pk_bf16(v1[0], v1[1]); w.w = cvt_pk_bf16(v1[2], v1[3]);
                    *(u32x4*)(rowp + bj * HALF) = w;
                    if (vt && tsp == vt_tile && colt < vt_cols) { const int row = row0 + ai * HALF + m * 16, c0 = col0 + bj * HALF; bf16_t* tp = vt + ((size_t)((row / kn_rows) * 8 + (c0 >> 6)) * 64 + (c0 & 63)) * kn_rows + (row % kn_rows);
#pragma unroll
                        for (int j = 0; j < 4; ++j) { tp[(size_t)(2 * j) * kn_rows] = (bf16_t)(w[j] & 0xffffu); tp[(size_t)(2 * j + 1) * kn_rows] = (bf16_t)(w[j] >> 16); } } } }
    }
};
struct EpiRes {
    static constexpr bool PERM = false, AFTER_DRAIN = false, MID = true;
    const float* base; float* out; int ldc; const float* gate; int rows_per_batch; int ldg; const float* ssq; float eps;
    __device__ __forceinline__ void group_ms(int row, float& m0, float& m1) const {
        const f32x4* p = (const f32x4*)(ssq + (size_t)row * 16); const f32x4 a = p[0], b = p[1], c = p[2], d = p[3];
        m0 = (((a[0] + a[1]) + (a[2] + a[3])) + ((b[0] + b[1]) + (b[2] + b[3]))) * (1.f / 512.f) + eps;
        m1 = (((c[0] + c[1]) + (c[2] + c[3])) + ((d[0] + d[1]) + (d[2] + d[3]))) * (1.f / 512.f) + eps; }
    __device__ __forceinline__ void mid(f32x4 (&acc)[2][2][4][2], const Unit& u, int wr, int fr) const {
#pragma unroll
        for (int ai = 0; ai < 2; ++ai)
#pragma unroll
            for (int m = 0; m < 4; ++m) { float m0, m1; group_ms(u.pm * BM + ai * HALF + wr * 64 + m * 16 + fr, m0, m1); const float ratio = sqrtf(m1 / m0);
#pragma unroll
                for (int bj = 0; bj < 2; ++bj)
#pragma unroll
                    for (int n = 0; n < 2; ++n) acc[ai][bj][m][n] = acc[ai][bj][m][n] * ratio; }
    }
    __device__ __forceinline__ void operator()(const f32x4 (&acc)[2][2][4][2], const Unit& u, int wr, int wc, int fr, int fq) const {
        const int col0 = u.pn * BM + wc * 32 + 4 * fq;
        const float* gp = gate + (size_t)((u.pm * BM) / rows_per_batch) * ldg + col0;
        f32x4 gv[2][2];
#pragma unroll
        for (int bj = 0; bj < 2; ++bj)
#pragma unroll
            for (int n = 0; n < 2; ++n) gv[bj][n] = *(const f32x4*)(gp + bj * HALF + n * 16) + 1.0f;
#pragma unroll
        for (int ai = 0; ai < 2; ++ai)
#pragma unroll
            for (int m = 0; m < 4; ++m) { const int row = u.pm * BM + ai * HALF + wr * 64 + m * 16 + fr; const size_t off = (size_t)row * ldc + col0;
                float m0, m1; group_ms(row, m0, m1); const float rfx = 1.0f / sqrtf(m1);
#pragma unroll
                for (int bj = 0; bj < 2; ++bj)
#pragma unroll
                    for (int n = 0; n < 2; ++n) { const f32x4 bs = *(const f32x4*)(base + off + bj * HALF + n * 16);
                        *(f32x4*)(out + off + bj * HALF + n * 16) = bs + gv[bj][n] * (acc[ai][bj][m][n] * rfx); }
                if (m & 1) asm volatile("" ::: "memory"); }
    }
};

template <class Epi, class Sched, bool ALIGN_EPI = false, bool SP2 = false>
__device__ __forceinline__ void gemm_phase(PG8_LAS unsigned char* lds, const Gemm g, const Sched& S, const Epi& E) {
    int tid_o = threadIdx.x; asm volatile("" : "+v"(tid_o));
    const int tid = tid_o, wid = __builtin_amdgcn_readfirstlane(tid >> 6), lane = tid & 63, wr = wid >> 2, wc = wid & 3, fr = lane & 15, fq = lane >> 4;
    const int K = g.K, nt = K / BK;
    unsigned voffA[2], voffB[2];
#pragma unroll
    for (int i = 0; i < 2; ++i) { int R, C; stage_rc(tid * 16 + i * 8192, R, C); const int Rb = Epi::PERM ? ((R & ~31) + perm32(R & 31)) : R;
        voffA[i] = (unsigned)(R * K + C) * 2u; voffB[i] = (unsigned)(Rb * K + C) * 2u; }
    const size_t kstep = (size_t)(BK * 2);
    const size_t hstep = (size_t)HALF * K * 2;
    const size_t tstep = 2 * hstep;
    const unsigned ldsw = (unsigned)wid * 1024u;
    const int aoff = lds_byte(wr * 64 + fr, fq * 8), boff = lds_byte(wc * 32 + fr, fq * 8);
#define PG8_SA(b, h) (((b) * 2 + (h)) * HTB)
#define PG8_SB(b, h) ((4 + (b) * 2 + (h)) * HTB)
#define PG8_STAGE(bufoff, gbase, voff) do { _Pragma("unroll") for (int _i = 0; _i < 2; ++_i) \
        __builtin_amdgcn_global_load_lds((const unsigned*)((const char*)(gbase) + (voff)[_i]), (PG8_LAS unsigned*)(lds + (bufoff) + ldsw + _i * 8192), 16, 0, 0); } while (0)
#define PG8_LDA(dst, b, h) do { _Pragma("unroll") for (int m = 0; m < 4; ++m) _Pragma("unroll") for (int k = 0; k < 2; ++k) dst[m][k] = *(const PG8_LAS bf16x8*)(lds + PG8_SA(b, h) + aoff + m * 2048 + k * 1024); } while (0)
#define PG8_LDB(dst, b, h) do { _Pragma("unroll") for (int n = 0; n < 2; ++n) _Pragma("unroll") for (int k = 0; k < 2; ++k) dst[n][k] = *(const PG8_LAS bf16x8*)(lds + PG8_SB(b, h) + boff + n * 2048 + k * 1024); } while (0)
#define PG8_MMA(ai, bj, At, Bt) do { __builtin_amdgcn_s_setprio(1); _Pragma("unroll") for (int m = 0; m < 4; ++m) _Pragma("unroll") for (int n = 0; n < 2; ++n) _Pragma("unroll") for (int k = 0; k < 2; ++k) \
        acc[ai][bj][m][n] = __builtin_amdgcn_mfma_f32_16x16x32_bf16(Bt[n][k], At[m][k], acc[ai][bj][m][n], 0, 0, 0); __builtin_amdgcn_s_setprio(0); } while (0)
#define PG8_WAIT_V(n) asm volatile("s_waitcnt vmcnt(" #n ")" ::: "memory")
#define PG8_WAIT_L(n) asm volatile("s_waitcnt lgkmcnt(" #n ")" ::: "memory")
#define PG8_BAR __builtin_amdgcn_s_barrier()
#define PG8_SCHED __builtin_amdgcn_sched_barrier(0)
    Unit cur, nxt; int ui = 0;
    if (!S.next(0, cur)) return;
    f32x4 acc[2][2][4][2];
#pragma unroll
    for (int a = 0; a < 2; ++a)
#pragma unroll
        for (int b = 0; b < 2; ++b)
#pragma unroll
            for (int m = 0; m < 4; ++m)
#pragma unroll
                for (int n = 0; n < 2; ++n) acc[a][b][m][n] = (f32x4){0.f, 0.f, 0.f, 0.f};
    bf16x8 At[4][2], B0[2][2], B1[2][2];
    const char* cA = (const char*)g.A + (size_t)cur.pm * tstep; const char* cB = (const char*)g.Bt + (size_t)cur.pn * tstep;
    S.a_ready(cur);
    if constexpr (SP2) {
        PG8_STAGE(PG8_SB(0, 0), cB, voffB); PG8_STAGE(PG8_SB(0, 1), cB + hstep, voffB); PG8_STAGE(PG8_SA(0, 0), cA, voffA); PG8_STAGE(PG8_SA(0, 1), cA + hstep, voffA);
        if (wr == 1) PG8_BAR;
        PG8_WAIT_V(2); PG8_BAR;
        PG8_STAGE(PG8_SB(1, 0), cB + kstep, voffB); PG8_STAGE(PG8_SA(1, 0), cA + kstep, voffA); PG8_STAGE(PG8_SB(1, 1), cB + hstep + kstep, voffB);
        PG8_WAIT_V(6); PG8_BAR;
    } else {
        PG8_STAGE(PG8_SB(0, 0), cB, voffB); PG8_STAGE(PG8_SA(0, 0), cA, voffA); PG8_STAGE(PG8_SB(0, 1), cB + hstep, voffB); PG8_STAGE(PG8_SA(0, 1), cA + hstep, voffA);
        if (wr == 1) PG8_BAR;
        PG8_WAIT_V(4); PG8_BAR;
        PG8_STAGE(PG8_SB(1, 0), cB + kstep, voffB); PG8_STAGE(PG8_SA(1, 0), cA + kstep, voffA); PG8_STAGE(PG8_SB(1, 1), cB + hstep + kstep, voffB);
        PG8_WAIT_V(6); PG8_BAR;
    }
    for (;;) {
        const bool has_next = S.next(ui + 1, nxt);
        const char* nA = has_next ? (const char*)g.A + (size_t)nxt.pm * tstep : cA; const char* nB = has_next ? (const char*)g.Bt + (size_t)nxt.pn * tstep : cB;
        for (int t = 0; t < nt; t += 2) {
            if constexpr (Epi::MID) { if (t == nt / 2) E.mid(acc, cur, wr, fr); }
            const bool last = (t == nt - 2);
            const char* a1 = cA + (size_t)(t + 1) * kstep;
            const char* a2 = last ? nA : cA + (size_t)(t + 2) * kstep; const char* b2 = last ? nB : cB + (size_t)(t + 2) * kstep;
            const char* a3 = a2 + kstep; const char* b3 = b2 + kstep;
            if (last && has_next) S.a_ready(nxt);
            if constexpr (SP2) {
            PG8_LDB(B0, 0, 0); PG8_LDB(B1, 0, 1); PG8_SCHED; PG8_LDA(At, 0, 0); PG8_STAGE(PG8_SA(1, 1), a1 + hstep, voffA);
            PG8_WAIT_V(8); PG8_WAIT_L(0); PG8_BAR; PG8_MMA(0, 0, At, B0); PG8_MMA(0, 1, At, B1); PG8_BAR; PG8_SCHED;
            PG8_LDA(At, 0, 1); PG8_STAGE(PG8_SB(0, 0), b2, voffB); PG8_STAGE(PG8_SB(0, 1), b2 + hstep, voffB); PG8_STAGE(PG8_SA(0, 0), a2, voffA);
            PG8_WAIT_V(8); PG8_WAIT_L(0); PG8_BAR; PG8_MMA(1, 0, At, B0); PG8_MMA(1, 1, At, B1); PG8_BAR; PG8_SCHED;
            PG8_LDB(B0, 1, 0); PG8_LDB(B1, 1, 1); PG8_SCHED; PG8_LDA(At, 1, 0); PG8_STAGE(PG8_SA(0, 1), a2 + hstep, voffA);
            PG8_WAIT_V(8); PG8_WAIT_L(0); PG8_BAR; PG8_MMA(0, 0, At, B0); PG8_MMA(0, 1, At, B1); PG8_BAR; PG8_SCHED;
            PG8_LDA(At, 1, 1); PG8_STAGE(PG8_SB(1, 0), b3, voffB); PG8_STAGE(PG8_SB(1, 1), b3 + hstep, voffB); PG8_STAGE(PG8_SA(1, 0), a3, voffA);
            PG8_WAIT_V(8); PG8_WAIT_L(0); PG8_BAR; PG8_MMA(1, 0, At, B0); PG8_MMA(1, 1, At, B1); PG8_BAR; PG8_SCHED;
            } else {
            PG8_LDB(B0, 0, 0); PG8_SCHED; PG8_LDA(At, 0, 0); PG8_STAGE(PG8_SA(1, 1), a1 + hstep, voffA);
            PG8_WAIT_L(8); PG8_BAR; PG8_WAIT_L(0); PG8_MMA(0, 0, At, B0); PG8_BAR; PG8_SCHED;
            PG8_LDB(B1, 0, 1); PG8_STAGE(PG8_SB(0, 0), b2, voffB);
            PG8_BAR; PG8_WAIT_L(0); PG8_MMA(0, 1, At, B1); PG8_BAR;
            PG8_LDA(At, 0, 1); PG8_STAGE(PG8_SA(0, 0), a2, voffA);
            PG8_BAR; PG8_WAIT_L(0); PG8_MMA(1, 0, At, B0); PG8_BAR; PG8_SCHED;
            PG8_STAGE(PG8_SB(0, 1), b2 + hstep, voffB);
            PG8_WAIT_V(6); PG8_BAR; PG8_MMA(1, 1, At, B1); PG8_BAR;
            PG8_LDB(B0, 1, 0); PG8_SCHED; PG8_LDA(At, 1, 0); PG8_STAGE(PG8_SA(0, 1), a2 + hstep, voffA);
            PG8_WAIT_L(8); PG8_BAR; PG8_WAIT_L(0); PG8_MMA(0, 0, At, B0); PG8_BAR; PG8_SCHED;
            PG8_LDB(B1, 1, 1); PG8_STAGE(PG8_SB(1, 0), b3, voffB);
            PG8_BAR; PG8_WAIT_L(0); PG8_MMA(0, 1, At, B1); PG8_BAR;
            PG8_LDA(At, 1, 1); PG8_STAGE(PG8_SA(1, 0), a3, voffA);
            PG8_BAR; PG8_WAIT_L(0); PG8_MMA(1, 0, At, B0); PG8_BAR; PG8_SCHED;
            PG8_STAGE(PG8_SB(1, 1), b3 + hstep, voffB);
            PG8_WAIT_V(6); PG8_BAR; PG8_MMA(1, 1, At, B1); PG8_BAR;
            }
        }
        if constexpr (ALIGN_EPI) { if (wr == 0) PG8_BAR; }
        if constexpr (!Epi::AFTER_DRAIN) { E(acc, cur, wr, wc, fr, fq); S.done(cur); }
        if (!has_next) break;
#pragma unroll
        for (int a = 0; a < 2; ++a)
#pragma unroll
            for (int b = 0; b < 2; ++b)
#pragma unroll
                for (int m = 0; m < 4; ++m)
#pragma unroll
                    for (int n = 0; n < 2; ++n) acc[a][b][m][n] = (f32x4){0.f, 0.f, 0.f, 0.f};
        cur = nxt; cA = nA; cB = nB; ++ui;
        if constexpr (ALIGN_EPI) { if (wr == 1) PG8_BAR; }
    }
    PG8_WAIT_V(0);
    if constexpr (!ALIGN_EPI) { if (wr == 0) PG8_BAR; }
    PG8_BAR;
    if constexpr (Epi::AFTER_DRAIN) { E.fused(acc, cur, wr, wc, fr, fq, lds, wid, lane); S.done(cur); }
#undef PG8_SA
#undef PG8_SB
#undef PG8_STAGE
#undef PG8_LDA
#undef PG8_LDB
#undef PG8_MMA
#undef PG8_WAIT_V
#undef PG8_WAIT_L
#undef PG8_BAR
#undef PG8_SCHED
}
}

#ifndef PG8_SP2
#define PG8_SP2 true
#endif
#ifndef PG8_ALIGN
#define PG8_ALIGN true
#endif
#include <hip/hip_bf16.h>
#include <cmath>
namespace attn_body {
using bf16=__hip_bfloat16;
using bf16x8=__attribute__((ext_vector_type(8)))short;
using s16x4=__attribute__((ext_vector_type(4)))short;
using f32x16=__attribute__((ext_vector_type(16)))float;
using u32x4=__attribute__((ext_vector_type(4)))unsigned;
using f32x4v=__attribute__((ext_vector_type(4)))float;
constexpr int BATCH=2,NHEAD=16,SEQ=8192,D=64,DM=NHEAD*D;
constexpr int NW=8,QBLK=32,QB=QBLK*NW,KVBLK=64,NQB=SEQ/QB;
constexpr int ATTN_PITCH=DM, ATTN_UNIT_ROWS=QB;
__device__ __forceinline__ int crow(int r,int hi){return (r&3)+8*(r>>2)+4*hi;}
#define SBAR() __builtin_amdgcn_sched_barrier(0)
__device__ __forceinline__ void cmask(f32x16&p0,f32x16&p1,int jb,int qrel,int hi){
  const float NEG=-INFINITY; int kb=64*jb+4*hi;
  #pragma unroll
  for(int r=0;r<16;++r){int kv=kb+(r&3)+8*(r>>2); if(kv>qrel)p0[r]=NEG; if(kv+32>qrel)p1[r]=NEG;}
}

constexpr int NSLOT=3, SLOTB=8192;
constexpr int LDS_K=0, LDS_V=NSLOT*SLOTB, LDS_WS=2*NSLOT*SLOTB, LDS_OST=LDS_WS+NW*64*4, LDS_BIAS=LDS_OST+NW*4096, LDS_BYTES=LDS_BIAS+SEQ*4+256+1024;
constexpr float C2=0.125f*1.4426950408889634f;
__device__ __forceinline__ void glds16(const void*gsrc,unsigned lds_dst){unsigned keep;
  asm volatile("s_mov_b32 %0, m0\n\ts_mov_b32 m0, %2\n\ts_nop 0\n\tglobal_load_lds_dwordx4 %1, off\n\ts_mov_b32 m0, %0":"=&s"(keep):"v"(gsrc),"s"(lds_dst):"memory");}
__device__ __forceinline__ float max3f(float a,float b,float c){float r;asm("v_max3_f32 %0, %1, %2, %3":"=v"(r):"v"(a),"v"(b),"v"(c));return r;}
__device__ __forceinline__ float max2f(float a,float b){float r;asm("v_max_f32_e32 %0, %1, %2":"=v"(r):"v"(a),"v"(b));return r;}
__device__ __forceinline__ float fadd_s(float a,float b){float r;asm("v_add_f32_e32 %0, %1, %2":"=v"(r):"v"(a),"v"(b));return r;}
__device__ __forceinline__ float fsub_s(float a,float b){float r;asm("v_sub_f32_e32 %0, %1, %2":"=v"(r):"v"(a),"v"(b));return r;}
typedef float f32x2_t __attribute__((ext_vector_type(2))); typedef __bf16 bf16x2_t __attribute__((ext_vector_type(2)));
__device__ __forceinline__ unsigned cvtpk_s(float lo,float hi){f32x2_t v={lo,hi};bf16x2_t b=__builtin_convertvector(v,bf16x2_t);return __builtin_bit_cast(unsigned,b);}
#define WAIT_BAR(N) asm volatile("s_waitcnt vmcnt(" #N ") lgkmcnt(0)\n\ts_barrier":::"memory")
__device__ __forceinline__ float silu2(float x){ return x*__builtin_amdgcn_rcpf(1.0f+__builtin_amdgcn_exp2f(-1.4426950408889634f*x)); }

__device__ __forceinline__ void qkt(f32x16&p0,f32x16&p1,const char*Kslot,const bf16x8*qr,int r32,int hi){
  const char*kb=Kslot+hi*1024+r32*16;
  #pragma unroll
  for(int d0=0;d0<4;++d0){
    const bf16x8 b0=*reinterpret_cast<const bf16x8*>(kb+d0*2048);
    const bf16x8 b1=*reinterpret_cast<const bf16x8*>(kb+d0*2048+512);
    {p0=__builtin_amdgcn_mfma_f32_32x32x16_bf16(b0,qr[d0],p0,0,0,0);p1=__builtin_amdgcn_mfma_f32_32x32x16_bf16(b1,qr[d0],p1,0,0,0);}}
}
typedef __attribute__((address_space(3))) const char* lds_cptr;
typedef short v4i16_t __attribute__((ext_vector_type(4)));
__device__ __forceinline__ void kload8(bf16x8*kf,lds_cptr kp){
  kf[0]=*(const __attribute__((address_space(3))) bf16x8*)(kp);      kf[1]=*(const __attribute__((address_space(3))) bf16x8*)(kp+512);
  kf[2]=*(const __attribute__((address_space(3))) bf16x8*)(kp+2048); kf[3]=*(const __attribute__((address_space(3))) bf16x8*)(kp+2560);
  kf[4]=*(const __attribute__((address_space(3))) bf16x8*)(kp+4096); kf[5]=*(const __attribute__((address_space(3))) bf16x8*)(kp+4608);
  kf[6]=*(const __attribute__((address_space(3))) bf16x8*)(kp+6144); kf[7]=*(const __attribute__((address_space(3))) bf16x8*)(kp+6656);
}
__device__ __forceinline__ void kload2(bf16x8*kf,lds_cptr kp,int j){ kf[2*j]=*(const __attribute__((address_space(3))) bf16x8*)(kp+j*2048); kf[2*j+1]=*(const __attribute__((address_space(3))) bf16x8*)(kp+j*2048+512); }
__device__ __forceinline__ s16x4 vtr(lds_cptr p){ return __builtin_bit_cast(s16x4,__builtin_amdgcn_ds_read_tr16_b64_v4i16((__attribute__((address_space(3))) v4i16_t*)p)); }
__device__ __forceinline__ float rowmax(const f32x16&p0,const f32x16&p1){
  float a=max3f(p0[0],p0[1],p1[0]),b=max3f(p0[2],p0[3],p1[1]);a=max3f(a,p1[2],p1[3]);
  #pragma unroll
  for(int r=4;r<16;r+=4){a=max3f(a,p0[r],p0[r+1]);b=max3f(b,p0[r+2],p0[r+3]);a=max3f(a,p1[r],p1[r+1]);b=max3f(b,p1[r+2],p1[r+3]);}
  const float m=max2f(a,b);
  auto rr=__builtin_amdgcn_permlane32_swap(__float_as_uint(m),__float_as_uint(m),false,false);
  return max2f(__uint_as_float(rr[0]),__uint_as_float(rr[1]));
}
__device__ __forceinline__ void pv(f32x16*o,int vb,bf16x8 pa0,bf16x8 pa1,bf16x8 pa2,bf16x8 pa3){
  #pragma unroll
  for(int d0=0;d0<2;++d0){s16x4 lo[4],hi[4];
    #pragma unroll
    for(int ks=0;ks<4;++ks){
      asm volatile("ds_read_b64_tr_b16 %0,%1 offset:%c2":"=&v"(lo[ks]):"v"(vb),"i"(d0*4096+ks*1024):"memory");
      asm volatile("ds_read_b64_tr_b16 %0,%1 offset:%c2":"=&v"(hi[ks]):"v"(vb),"i"(d0*4096+ks*1024+512):"memory");}
    asm volatile("s_waitcnt lgkmcnt(0)":::"memory");SBAR();
    #define PK(k) (bf16x8){lo[k][0],lo[k][1],lo[k][2],lo[k][3],hi[k][0],hi[k][1],hi[k][2],hi[k][3]}
    o[d0]=__builtin_amdgcn_mfma_f32_32x32x16_bf16(pa0,PK(0),o[d0],0,0,0);
    o[d0]=__builtin_amdgcn_mfma_f32_32x32x16_bf16(pa1,PK(1),o[d0],0,0,0);
    o[d0]=__builtin_amdgcn_mfma_f32_32x32x16_bf16(pa2,PK(2),o[d0],0,0,0);
    o[d0]=__builtin_amdgcn_mfma_f32_32x32x16_bf16(pa3,PK(3),o[d0],0,0,0);
    #undef PK
  }
}

#ifndef ATTN_STORE16
#define ATTN_STORE16(p,v) (*(u32x4*)(p)=(v))
#endif
template<int THRL> __device__ __forceinline__ void attn_unit(int b,int h,int qb,const bf16*Q,const bf16*__restrict__ K,const bf16*__restrict__ V,bf16*O,const float*__restrict__ cum,const unsigned*__restrict__ kn,const bf16*__restrict__ Gp,const float*__restrict__ ggrp,float*__restrict__ ssq,char*shm){
  int tid_o=threadIdx.x; asm volatile("":"+v"(tid_o)); const int tid=tid_o,lane=tid&63,r32=lane&31,hi=lane>>5; const int wid=__builtin_amdgcn_readfirstlane(tid>>6);
  const long rowbase=(long)b*SEQ; const int q0=qb*QB;
  const bf16*Qw=Q+(rowbase+q0+wid*QBLK)*DM+h*D;
  const unsigned lds0=(unsigned)(uintptr_t)shm;
  float*wsf=(float*)(shm+LDS_WS)+wid*64;
  int NT=(q0+QB)/KVBLK;
  typedef __attribute__((address_space(3))) float lds_f; typedef __attribute__((address_space(3))) f32x4v lds_f4;
  lds_f* const blp=(lds_f*)((__attribute__((address_space(3))) char*)shm+LDS_BIAS);
  lds_f* const knl=blp+SEQ+64;
  { int z_=0; asm volatile("":"+v"(z_)); const float cref=cum[q0+z_]; const int n4=(q0+QB)>>2;
    for(int i=tid;i<n4;i+=NW*64){ f32x4v v=*reinterpret_cast<const f32x4v*>(cum+4*i); v=cref-v; *(lds_f4*)(blp+4*i)=v; }
    if(tid<NT) knl[tid]=__builtin_sqrtf(__uint_as_float(kn[2*tid])+__uint_as_float(kn[2*tid+1])); }
  bf16x8 qr[4];
  #pragma unroll
  for(int d0=0;d0<4;++d0)qr[d0]=*reinterpret_cast<const bf16x8*>(&Qw[(long)r32*DM+d0*16+hi*8]);
  { float qs=0.f;
    #pragma unroll
    for(int d0=0;d0<4;++d0)
      #pragma unroll
      for(int j=0;j<8;++j){ const float v=__uint_as_float(((unsigned)(unsigned short)qr[d0][j])<<16); qs+=v*v; }
    { auto rr=__builtin_amdgcn_permlane32_swap(__float_as_uint(qs),__float_as_uint(qs),false,false); qs=__uint_as_float(rr[0])+__uint_as_float(rr[1]); }
    #pragma unroll
    for(int o_=1;o_<32;o_<<=1) qs=__builtin_fmaxf(qs,__shfl_xor(qs,o_));
    if(lane==0) knl[128+wid]=qs; }
  asm volatile("s_waitcnt vmcnt(0) lgkmcnt(0)\n\ts_barrier":::"memory");
  int t_start;
  { float q2=knl[128];
    #pragma unroll
    for(int w_=1;w_<NW;++w_) q2=__builtin_fmaxf(q2,knl[128+w_]);
    const float qm=1.03f*__builtin_sqrtf(q2);
    const float ksel=__builtin_fmaxf(__builtin_fmaxf(knl[NT-4],knl[NT-3]),__builtin_fmaxf(knl[NT-2],knl[NT-1]));
    const int t0_=lane,t1_=lane+64;
    const bool ok0=(t0_<NT-4)&&(blp[64*t0_+63]+qm*(knl[t0_]+ksel)<=-152.f);
    const bool ok1=(t1_<NT-4)&&(blp[64*t1_+63]+qm*(knl[t1_]+ksel)<=-152.f);
    const unsigned long long m0=~__ballot(ok0),m1=~__ballot(ok1);
    const int f0=m0?__builtin_ctzll(m0):64,f1=m1?__builtin_ctzll(m1):64;
    t_start=(f0<64)?f0:64+f1; t_start=(t_start>NT-4)?NT-4:t_start; t_start&=~1; t_start=__builtin_amdgcn_readfirstlane(t_start); }
  NT-=t_start;
  const bf16*Kh=K+(rowbase+(long)t_start*KVBLK)*DM+h*D,*Vh=V+(rowbase+(long)t_start*KVBLK)*DM+h*D;
  const bf16*ksrc=Kh+(long)lane*DM+wid*8;
  const bf16*vsrc=Vh+(long)(16*(wid&3)+(lane>>2))*DM+(wid>>2)*32+(lane&3)*8;
  const unsigned kdst=lds0+LDS_K+wid*1024, vdst=lds0+LDS_V+wid*1024;
  #define DMA_K(t,slot) glds16(ksrc+(long)(t)*KVBLK*DM,(unsigned)__builtin_amdgcn_readfirstlane(kdst+(slot)))
  #define DMA_V(t,slot) glds16(vsrc+(long)(t)*KVBLK*DM,(unsigned)__builtin_amdgcn_readfirstlane(vdst+(slot)))
  const int vb0=(int)(lds0+LDS_V)+((lane>>4)&1)*32+(lane&3)*8+(4*hi+((lane&15)>>2))*64;
  const char*Kbase=shm+LDS_K; bf16x8 kf[8];
  const lds_cptr shm3=(lds_cptr)shm; const lds_cptr kp0=shm3+LDS_K+hi*1024+r32*16; const lds_cptr vp0=shm3+LDS_V+((lane>>4)&1)*32+(lane&3)*8+(4*hi+((lane&15)>>2))*64;
  const lds_f* const bq0=blp+4*hi+t_start*KVBLK;
  DMA_K(0,0);DMA_V(0,0);DMA_K(1,SLOTB);
  float mhat=blp[q0+wid*QBLK+r32],l_reg=0.f;f32x16 o[2];o[0]=f32x16{};o[1]=f32x16{};
  const int qrel=wid*QBLK+r32;
  #define CMASK(P0,P1,t) do{int jb_=(t)-(NT-4); if(jb_>=0)cmask(P0,P1,jb_,qrel,hi);}while(0)
  bool resc=false;
  #define BINIT(P0,P1,t) do{ const lds_f* b_=bq0+(t)*KVBLK; _Pragma("unroll") for(int i_=0;i_<4;++i_){ const f32x4v x0_=*(const lds_f4*)(b_+8*i_), x1_=*(const lds_f4*)(b_+32+8*i_); \
      _Pragma("unroll") for(int k_=0;k_<4;++k_){ P0[4*i_+k_]=x0_[k_]-mhat; P1[4*i_+k_]=x1_[k_]-mhat; } } }while(0)
  #define START(P0,P1) do{ const float rm=rowmax(P0,P1); resc=false; \
    { const float dl=__builtin_fmaxf(rm,0.f); mhat=fadd_s(mhat,dl); \
      _Pragma("unroll") for(int r=0;r<16;++r){P0[r]=fsub_s(P0[r],dl);P1[r]=fsub_s(P1[r],dl);} \
      } \
    _Pragma("unroll") for(int r=0;r<16;++r)P0[r]=__builtin_amdgcn_exp2f(P0[r]); }while(0)
  #define RESC() do{ if(resc){ asm volatile("s_waitcnt lgkmcnt(0)":::"memory"); \
      _Pragma("unroll") for(int d_=0;d_<2;++d_) _Pragma("unroll") for(int r=0;r<16;++r)o[d_][r]*=wsf[crow(r,hi)]; } }while(0)
  f32x16 pA0,pA1,pB0,pB1;
  int sl_prev=0,sl_cur=0,sl_next=SLOTB;
  #define ROT() do{sl_prev=sl_cur;sl_cur=sl_next;sl_next=(sl_next==(NSLOT-1)*SLOTB)?0:sl_next+SLOTB;}while(0)
  DMA_K(2,2*SLOTB);
  WAIT_BAR(3);
  BINIT(pA0,pA1,0);
  qkt(pA0,pA1,Kbase,qr,r32,hi);asm volatile("s_nop 15\n\ts_nop 7":"+v"(pA0),"+v"(pA1));CMASK(pA0,pA1,0);
  START(pA0,pA1);
  _Pragma("unroll") for(int r=0;r<16;++r)pA1[r]=__builtin_amdgcn_exp2f(pA1[r]);
  BINIT(pB0,pB1,1);
  WAIT_BAR(0);
  DMA_K(3,0);DMA_V(1,SLOTB);
  ROT();
  kload8(kf,kp0+sl_cur);
  WAIT_BAR(2);
  s16x4 vlo[8],vhi[8]; u32x4 pw0,pw1,pw2,pw3;
  #define PKW(P,B) cvtpk_s(P[B],P[B+1])
  #define PAF(k) __builtin_bit_cast(bf16x8,pw##k)
  #define VFR(i) (bf16x8){vlo[i][0],vlo[i][1],vlo[i][2],vlo[i][3],vhi[i][0],vhi[i][1],vhi[i][2],vhi[i][3]}
  #define PIN(x) asm volatile("":"+v"(x))
  #define MX3(a,b,c) __builtin_fmaxf(__builtin_fmaxf((a),(b)),(c))
  #define GAPA(MF,A0,A1,A2,A3,W0,W1,PW) do{ MF; sacc+=A0; sacc+=A1; sacc+=A2; sacc+=A3; PIN(sacc); W0; W1; PIN(PW); SBAR(); }while(0)
  #define EX(v) __builtin_amdgcn_exp2f(v)
  #define GAPB(MF,X,B,XTRA) do{ MF; X[B]=EX(X[B]); X[B+1]=EX(X[B+1]); X[B+2]=EX(X[B+2]); X[B+3]=EX(X[B+3]); PIN(X); XTRA; SBAR(); }while(0)
  #define BLD(dst,off) dst=*(const lds_f4*)(bqn_+(off))
  #define BSB(P,i,src) do{ P[4*(i)]=src[0]-mhat; P[4*(i)+1]=src[1]-mhat; P[4*(i)+2]=src[2]-mhat; P[4*(i)+3]=src[3]-mhat; PIN(P); }while(0)
  #define VRD(i) do{ vlo[i]=vtr(vp_+(((i)>>2)*4096+((i)&3)*1024)); vhi[i]=vtr(vp_+(((i)>>2)*4096+((i)&3)*1024+512)); }while(0)
  #define KRD(G,j) do{ if(G){ kload2(kf,kp0+sl_next,j); SBAR(); } }while(0)
  #define STEP(C0,C1,P0,P1,t,GK,GV,GL) do{ SBAR(); \
    const lds_cptr vp_=vp0+sl_prev; const lds_f* const bqn_=bq0+((t)+1)*KVBLK; f32x4v bta_,btb_; \
    VRD(0); SBAR(); float sacc=(P0[0]+P0[1]); \
    GAPA(C0=__builtin_amdgcn_mfma_f32_32x32x16_bf16(kf[0],qr[0],C0,0,0,0), P0[2],P0[3],P0[4],P0[5],     pw0[0]=PKW(P0,0), pw0[1]=PKW(P0,2), pw0); \
    VRD(4); SBAR(); GAPA(C1=__builtin_amdgcn_mfma_f32_32x32x16_bf16(kf[1],qr[0],C1,0,0,0), P0[6],P0[7],P0[8],P0[9],     pw0[2]=PKW(P0,4), pw0[3]=PKW(P0,6), pw0); \
    VRD(1); SBAR(); GAPA(C0=__builtin_amdgcn_mfma_f32_32x32x16_bf16(kf[2],qr[1],C0,0,0,0),   P0[10],P0[11],P0[12],P0[13], pw1[0]=PKW(P0,8), pw1[1]=PKW(P0,10), pw1); \
    VRD(5); SBAR(); GAPA(C1=__builtin_amdgcn_mfma_f32_32x32x16_bf16(kf[3],qr[1],C1,0,0,0),   P0[14],P0[15],P1[0],P1[1],   pw1[2]=PKW(P0,12),pw1[3]=PKW(P0,14), pw1); \
    VRD(2); SBAR(); GAPA(C0=__builtin_amdgcn_mfma_f32_32x32x16_bf16(kf[4],qr[2],C0,0,0,0),   P1[2],P1[3],P1[4],P1[5],     pw2[0]=PKW(P1,0), pw2[1]=PKW(P1,2), pw2); \
    VRD(6); SBAR(); GAPA(C1=__builtin_amdgcn_mfma_f32_32x32x16_bf16(kf[5],qr[2],C1,0,0,0),   P1[6],P1[7],P1[8],P1[9],     pw2[2]=PKW(P1,4), pw2[3]=PKW(P1,6), pw2); \
    VRD(3); SBAR(); GAPA(C0=__builtin_amdgcn_mfma_f32_32x32x16_bf16(kf[6],qr[3],C0,0,0,0),   P1[10],P1[11],P1[12],P1[13], pw3[0]=PKW(P1,8), pw3[1]=PKW(P1,10), pw3); \
    VRD(7); SBAR(); GAPA(C1=__builtin_amdgcn_mfma_f32_32x32x16_bf16(kf[7],qr[3],C1,0,0,0),   P1[14],P1[15],0.f,0.f,       pw3[2]=PKW(P1,12),pw3[3]=PKW(P1,14), pw3); \
    l_reg+=sacc; \
    if(GK){DMA_K((t)+3,sl_cur);} if(GV){DMA_V((t)+1,sl_next);} \
    CMASK(C0,C1,t); \
    { float a=MX3(C0[0],C0[1],C1[0]),b=MX3(C0[2],C0[3],C1[1]); a=MX3(a,C1[2],C1[3]); \
      _Pragma("unroll") for(int r=4;r<16;r+=4){a=MX3(a,C0[r],C0[r+1]);b=MX3(b,C0[r+2],C0[r+3]);a=MX3(a,C1[r],C1[r+1]);b=MX3(b,C1[r+2],C1[r+3]);} \
      float rm=__builtin_fmaxf(a,b); { auto rr=__builtin_amdgcn_permlane32_swap(__float_as_uint(rm),__float_as_uint(rm),false,false); rm=__builtin_fmaxf(__uint_as_float(rr[0]),__uint_as_float(rr[1])); } \
      resc=false; \
      if(__builtin_expect(__any(rm>(float)THRL),0)){ const float dl=__builtin_fmaxf(rm,0.f); mhat+=dl; \
        _Pragma("unroll") for(int r=0;r<16;++r){C0[r]-=dl;C1[r]-=dl;} \
        const float f=__builtin_amdgcn_exp2f(-dl); l_reg*=f; if(hi==0)wsf[r32]=f; resc=true; } } \
    SBAR(); \
    GAPB(o[0]=__builtin_amdgcn_mfma_f32_32x32x16_bf16(PAF(0),VFR(0),o[0],0,0,0), C0,0, BLD(bta_,0)); \
    GAPB(o[1]=__builtin_amdgcn_mfma_f32_32x32x16_bf16(PAF(0),VFR(4),o[1],0,0,0), C0,4, BLD(btb_,8);BSB(P0,0,bta_)); \
    KRD(GL,0); GAPB(o[0]=__builtin_amdgcn_mfma_f32_32x32x16_bf16(PAF(1),VFR(1),o[0],0,0,0), C0,8, BLD(bta_,16);BSB(P0,1,btb_)); \
    KRD(GL,1); GAPB(o[1]=__builtin_amdgcn_mfma_f32_32x32x16_bf16(PAF(1),VFR(5),o[1],0,0,0), C0,12, BLD(btb_,24);BSB(P0,2,bta_)); \
    KRD(GL,2); GAPB(o[0]=__builtin_amdgcn_mfma_f32_32x32x16_bf16(PAF(2),VFR(2),o[0],0,0,0), C1,0, BLD(bta_,32);BSB(P0,3,btb_)); \
    KRD(GL,3); GAPB(o[1]=__builtin_amdgcn_mfma_f32_32x32x16_bf16(PAF(2),VFR(6),o[1],0,0,0), C1,4, BLD(btb_,40);BSB(P1,0,bta_)); \
    GAPB(o[0]=__builtin_amdgcn_mfma_f32_32x32x16_bf16(PAF(3),VFR(3),o[0],0,0,0), C1,8, BLD(bta_,48);BSB(P1,1,btb_)); \
    GAPB(o[1]=__builtin_amdgcn_mfma_f32_32x32x16_bf16(PAF(3),VFR(7),o[1],0,0,0), C1,12, BLD(btb_,56);BSB(P1,2,bta_)); \
    BSB(P1,3,btb_); \
    }while(0)
  int t=1;
  #undef CMASK
  #define CMASK(P0,P1,t) do{}while(0)
  for(;t+5<NT;t+=2){
    STEP(pB0,pB1,pA0,pA1,t,true,true,true);     WAIT_BAR(2); RESC(); ROT();
    STEP(pA0,pA1,pB0,pB1,t+1,true,true,true);   WAIT_BAR(2); RESC(); ROT();
  }
  #undef CMASK
  #define CMASK(P0,P1,t) do{int jb_=(t)-(NT-4); if(jb_>=0)cmask(P0,P1,jb_,qrel,hi);}while(0)
  #define ENDW(tt) do{ if((tt)+3<NT){WAIT_BAR(2);} else if((tt)+2<NT){WAIT_BAR(1);} else {WAIT_BAR(0);} }while(0)
  for(;t+1<NT;t+=2){
    STEP(pB0,pB1,pA0,pA1,t,(t+3<NT),(t+1<NT),(t+1<NT));       ENDW(t);   RESC(); ROT();
    STEP(pA0,pA1,pB0,pB1,t+1,(t+4<NT),(t+2<NT),(t+2<NT));     ENDW(t+1); RESC(); ROT();
  }
  STEP(pB0,pB1,pA0,pA1,NT-1,false,false,false); RESC();
  { float sacc=pB0[0]+pB0[1]; _Pragma("unroll") for(int r=2;r<16;++r)sacc+=pB0[r]; _Pragma("unroll") for(int r=0;r<16;++r)sacc+=pB1[r]; l_reg+=sacc;
    pw0=(u32x4){PKW(pB0,0),PKW(pB0,2),PKW(pB0,4),PKW(pB0,6)};pw1=(u32x4){PKW(pB0,8),PKW(pB0,10),PKW(pB0,12),PKW(pB0,14)};pw2=(u32x4){PKW(pB1,0),PKW(pB1,2),PKW(pB1,4),PKW(pB1,6)};pw3=(u32x4){PKW(pB1,8),PKW(pB1,10),PKW(pB1,12),PKW(pB1,14)};
    SBAR(); pv(o,vb0+sl_cur,PAF(0),PAF(1),PAF(2),PAF(3)); }
  #undef PKW
  #undef PAF
  #undef VFR
  #undef PIN
  #undef MX3
  #undef GAPA
  #undef GAPB
  #undef BLD
  #undef BSB
  #undef BINIT
  #undef EX
  #undef VRD
  #undef KRD
  #undef STEP
  #undef ENDW
  {auto rr=__builtin_amdgcn_permlane32_swap(__float_as_uint(l_reg),__float_as_uint(l_reg),false,false);l_reg=__uint_as_float(rr[0])+__uint_as_float(rr[1]);}
  if(hi==0)wsf[32+r32]=l_reg;asm volatile("s_waitcnt lgkmcnt(0)":::"memory");
  float rli[16];
  #pragma unroll
  for(int r=0;r<16;++r)rli[r]=__builtin_amdgcn_rcpf(wsf[32+crow(r,hi)]);
  bf16*Ow=O+(rowbase+q0+wid*QBLK)*DM+h*D;
  { bf16*stg=(bf16*)(shm+LDS_OST)+wid*2048;
    #pragma unroll
    for(int r=0;r<16;++r){const int orow=crow(r,hi);
      #pragma unroll
      for(int d0=0;d0<2;++d0)stg[orow*64+d0*32+r32]=__float2bfloat16(o[d0][r]*rli[r]);}
    asm volatile("s_waitcnt lgkmcnt(0)":::"memory");
    const int ch=lane&7; const bf16*Gw=Gp+(rowbase+q0+wid*QBLK)*DM+h*D;
    const f32x4v ga=*reinterpret_cast<const f32x4v*>(ggrp+h*D+ch*8),gb=*reinterpret_cast<const f32x4v*>(ggrp+h*D+ch*8+4);
    const float gg[8]={ga[0],ga[1],ga[2],ga[3],gb[0],gb[1],gb[2],gb[3]};
    #pragma unroll
    for(int i=0;i<4;++i){const int row=i*8+(lane>>3); const u32x4 v=*(const u32x4*)(stg+row*64+ch*8); const u32x4 gv=*reinterpret_cast<const u32x4*>(Gw+(long)row*DM+ch*8);
      float s=0.f; u32x4 y;
      #pragma unroll
      for(int k=0;k<4;++k){ const float a0=__uint_as_float(v[k]<<16),a1=__uint_as_float(v[k]&0xffff0000u),g0=__uint_as_float(gv[k]<<16),g1=__uint_as_float(gv[k]&0xffff0000u);
        s+=a0*a0+a1*a1; y[k]=cvtpk_s(a0*gg[2*k]*silu2(g0),a1*gg[2*k+1]*silu2(g1)); }
      s+=__shfl_xor(s,1); s+=__shfl_xor(s,2); s+=__shfl_xor(s,4);
      if(ch==0)ssq[(rowbase+q0+wid*QBLK+row)*16+h]=s;
      ATTN_STORE16(Ow+(long)row*DM+ch*8,y);} }
  asm volatile("s_waitcnt lgkmcnt(0)\n\ts_barrier":::"memory");
  #undef DMA_K
  #undef DMA_V
  #undef CMASK
  #undef START
  #undef RESC
  #undef ROT
}
constexpr int ATTN_LDS_BYTES=LDS_BYTES;
constexpr float SB_EXIT=150.f;
__device__ __forceinline__ void sb_unit(int b,int h,int qb,const bf16*Q,const bf16*__restrict__ K,const bf16*__restrict__ VT,bf16*O,const bf16*__restrict__ Gp,const float*__restrict__ ggrp,float*__restrict__ ssq){
  int tid_o=threadIdx.x; asm volatile("":"+v"(tid_o)); const int tid=tid_o,lane=tid&63,r32=lane&31,hi=lane>>5; const int wid=__builtin_amdgcn_readfirstlane(tid>>6);
  const long rowbase=(long)b*SEQ; const int q0=qb*QB+wid*QBLK;
  const bf16*Qw=Q+(rowbase+q0)*DM+h*D;
  const int pi=16*((r32>>2)&1)+(r32&3)+4*(r32>>3);
  const bf16*Kl=K+(rowbase+pi)*DM+h*D+hi*8;
  const bf16*Vl=VT+((long)((b*8+h)*64+r32))*SEQ+16*hi;
  bf16x8 qr[4];
  #pragma unroll
  for(int d0=0;d0<4;++d0)qr[d0]=*reinterpret_cast<const bf16x8*>(&Qw[(long)r32*DM+d0*16+hi*8]);
  f32x16 o0=f32x16{},o1=f32x16{};
  float carry=0.f; const int qabs=q0+r32; const int ktd=q0>>5;
  bf16x8 kc[4],vc[4],kx[4],vx[4];
  #define SB_LOAD(KF,VF,kt_) do{ const bf16*kp_=Kl+(long)(kt_)*32*DM; const bf16*vp_=Vl+(kt_)*32; \
    _Pragma("unroll") for(int d0=0;d0<4;++d0)KF[d0]=*reinterpret_cast<const bf16x8*>(kp_+16*d0); \
    VF[0]=*reinterpret_cast<const bf16x8*>(vp_); VF[1]=*reinterpret_cast<const bf16x8*>(vp_+8); VF[2]=*reinterpret_cast<const bf16x8*>(vp_+32*SEQ); VF[3]=*reinterpret_cast<const bf16x8*>(vp_+32*SEQ+8); }while(0)
  SB_LOAD(kc,vc,ktd);
  for(int kt=ktd;kt>=0;--kt){
    const int kbase=kt*32;
    { const int ktn=kt>0?kt-1:0; SB_LOAD(kx,vx,ktn); }
    f32x16 p=f32x16{};
    p=__builtin_amdgcn_mfma_f32_32x32x16_bf16(kc[0],qr[0],p,0,0,0);p=__builtin_amdgcn_mfma_f32_32x32x16_bf16(kc[1],qr[1],p,0,0,0);
    p=__builtin_amdgcn_mfma_f32_32x32x16_bf16(kc[2],qr[2],p,0,0,0);p=__builtin_amdgcn_mfma_f32_32x32x16_bf16(kc[3],qr[3],p,0,0,0);
    const bool diag=(kt==ktd); const int key0=kbase+16*hi;
    float l2[16];
    #pragma unroll
    for(int r=0;r<16;++r){ const float t=p[r]; float l=__builtin_amdgcn_logf(1.0f+__builtin_amdgcn_exp2f(t)); l=(t>30.f)?t:l;
      if(diag){ if(key0+r>=qabs)l=0.f; } l2[r]=l; }
    float g[4];
    #pragma unroll
    for(int i=0;i<4;++i)g[i]=(l2[4*i]+l2[4*i+1])+(l2[4*i+2]+l2[4*i+3]);
    const float tot=(g[0]+g[1])+(g[2]+g[3]);
    float pt; { auto rr=__builtin_amdgcn_permlane32_swap(__float_as_uint(tot),__float_as_uint(tot),false,false); const unsigned tu=__float_as_uint(tot); pt=__uint_as_float(rr[0]==tu?rr[1]:rr[0]); }
    float suf[4]; suf[3]=carry+(hi?0.f:pt); suf[2]=suf[3]+g[3]; suf[1]=suf[2]+g[2]; suf[0]=suf[1]+g[1];
    carry+=tot+pt;
    float a[16];
    #pragma unroll
    for(int i=0;i<4;++i){ float c=suf[i];
      #pragma unroll
      for(int k=3;k>=0;--k){ const int r=4*i+k; c+=l2[r]; float av=__builtin_amdgcn_exp2f(p[r]-c); if(diag){ if(key0+r>=qabs)av=0.f; } a[r]=av; } }
    u32x4 w0,w1; w0[0]=cvtpk_s(a[0],a[1]);w0[1]=cvtpk_s(a[2],a[3]);w0[2]=cvtpk_s(a[4],a[5]);w0[3]=cvtpk_s(a[6],a[7]);
    w1[0]=cvtpk_s(a[8],a[9]);w1[1]=cvtpk_s(a[10],a[11]);w1[2]=cvtpk_s(a[12],a[13]);w1[3]=cvtpk_s(a[14],a[15]);
    const bf16x8 pa0=__builtin_bit_cast(bf16x8,w0),pa1=__builtin_bit_cast(bf16x8,w1);
    o0=__builtin_amdgcn_mfma_f32_32x32x16_bf16(pa0,vc[0],o0,0,0,0);o1=__builtin_amdgcn_mfma_f32_32x32x16_bf16(pa0,vc[2],o1,0,0,0);
    o0=__builtin_amdgcn_mfma_f32_32x32x16_bf16(pa1,vc[1],o0,0,0,0);o1=__builtin_amdgcn_mfma_f32_32x32x16_bf16(pa1,vc[3],o1,0,0,0);
    if(__all(carry>=SB_EXIT))break;
    #pragma unroll
    for(int d0=0;d0<4;++d0){kc[d0]=kx[d0];vc[d0]=vx[d0];}
  }
  #undef SB_LOAD
  unsigned short*Ow=(unsigned short*)(O+(rowbase+q0)*DM+h*D);
  const unsigned short*Gw=(const unsigned short*)(Gp+(rowbase+q0)*DM+h*D); const float gg0=ggrp[h*D+r32],gg1=ggrp[h*D+32+r32];
  #pragma unroll
  for(int r=0;r<16;++r){ const long ro=(long)crow(r,hi)*DM; const float a0=o0[r],a1=o1[r];
    float s=a0*a0+a1*a1;
    #pragma unroll
    for(int o_=1;o_<32;o_<<=1)s+=__shfl_xor(s,o_);
    if(r32==0)ssq[(rowbase+q0+crow(r,hi))*16+h]=s;
    const float g0=__uint_as_float(((unsigned)Gw[ro+r32])<<16),g1=__uint_as_float(((unsigned)Gw[ro+32+r32])<<16);
    const unsigned w=cvtpk_s(a0*gg0*silu2(g0),a1*gg1*silu2(g1));
    Ow[ro+r32]=(unsigned short)(w&0xffffu); Ow[ro+32+r32]=(unsigned short)(w>>16); }
}
struct AttnTensors { const bf16* Q; const bf16* K; const bf16* V; bf16* O; const float* cum; };

#undef SBAR
#undef WAIT_BAR
}
constexpr int NWAVES = 8;
#ifndef PROBE_DUP
#define PROBE_DUP 0
#endif
#ifndef MK_PER_PHASE
#define MK_PER_PHASE 0
#endif
constexpr int BATCH = 2, T = 8192, D = 1024, DEPTH = 4, NHEADS = 16, HD = 64;
constexpr int M = BATCH * T;
constexpr int D_IN = 4104, NPROJ = 4096;
constexpr float EPS = 1e-6f, LOG2E = 1.4426950408889634f;
constexpr size_t MiB = 1u << 20;
constexpr size_t WS_CTL = 0, CTL_ZERO_BYTES = 256 * 1024;
constexpr size_t WS_BAR = 16 * 1024, WS_QCTR = 32 * 1024, WS_KN = 64 * 1024;
constexpr size_t WS_BAR_UNUSED_ = 0;
constexpr size_t WS_ADA = 512 * 1024;
constexpr size_t WS_LOGF = 1 * MiB;
constexpr size_t WS_CUM = WS_LOGF + 512 * 1024;
constexpr size_t WS_WIN = 2 * MiB;
constexpr size_t WS_WOUT = WS_WIN + (size_t)DEPTH * NPROJ * D * 2;
constexpr size_t WS_XN = 42 * MiB;
constexpr size_t WS_QO = 74 * MiB, WS_K = 106 * MiB, WS_V = 138 * MiB, WS_G = 170 * MiB, WS_O = 202 * MiB, WS_SSQ = 234 * MiB, WS_VT = 235 * MiB, WS_END = 251 * MiB;
static_assert(WS_WOUT + (size_t)DEPTH * D * D * 2 <= WS_XN && WS_XN + (size_t)M * D * 2 <= WS_QO, "d_ws map");
constexpr int RING_BYTES = 131072, LDS_BYTES = 147456, MISC_OFF = RING_BYTES + 320, BARST_OFF = MISC_OFF + 64;
static_assert(attn_body::ATTN_LDS_BYTES <= RING_BYTES, "attention LDS");

#define GAS __attribute__((address_space(1)))
#define LAS __attribute__((address_space(3)))
typedef unsigned short bf16;
typedef unsigned v4u __attribute__((ext_vector_type(4)));
typedef float f32x4 __attribute__((ext_vector_type(4)));
#define LDS_WAIT() asm volatile("s_waitcnt lgkmcnt(0)" ::: "memory")
__device__ __forceinline__ unsigned f2bf(float f) { unsigned u = __builtin_bit_cast(unsigned, f); return (u + 0x7fffu + ((u >> 16) & 1u)) >> 16; }
__device__ __forceinline__ unsigned pk2(float lo, float hi) { return f2bf(lo) | (f2bf(hi) << 16); }
__device__ __forceinline__ float bf_lo(unsigned w) { return __uint_as_float(w << 16); }
__device__ __forceinline__ float bf_hi(unsigned w) { return __uint_as_float(w & 0xffff0000u); }
__device__ __forceinline__ float wave_sum(float v) {
#pragma unroll
    for (int o = 1; o < 64; o <<= 1) v += __shfl_xor(v, o);
    return v;
}
__device__ __forceinline__ void transpose_item(const float* W, int ldw, int k0, int n0, bf16* WT, int ldt, int drow0, LAS float* scr, int lane) {
#pragma unroll 8
    for (int i = 0; i < 32; ++i) { const int kk = 2 * i + (lane >> 5); scr[kk * 33 + (lane & 31)] = W[(size_t)(k0 + kk) * ldw + n0 + (lane & 31)]; }
    LDS_WAIT(); asm volatile("" ::: "memory");
    const int c = lane & 7;
#pragma unroll
    for (int j = 0; j < 4; ++j) { const int n = (lane >> 3) + 8 * j; const LAS float* s = scr + (8 * c) * 33 + n;
        v4u o; o.x = pk2(s[0 * 33], s[1 * 33]); o.y = pk2(s[2 * 33], s[3 * 33]); o.z = pk2(s[4 * 33], s[5 * 33]); o.w = pk2(s[6 * 33], s[7 * 33]);
        *(v4u*)(WT + (size_t)(drow0 + n) * ldt + k0 + 8 * c) = o; }
    LDS_WAIT(); asm volatile("" ::: "memory");
}
__device__ __forceinline__ float silu_f(float x) { return x * __builtin_amdgcn_rcpf(1.0f + __builtin_amdgcn_exp2f(-x * LOG2E)); }

#define XB_TMO      128
#define XB_XCNT(j)  (256  + 64 * (j))
#define XB_XSUB(j)  (1280 + 64 * (j))
#define XB_XGEN(j)  (2304 + 64 * (j))
#define XB_TOP      3328
#define XB_TOPGEN   3392
#define XCD_BAR_WORDS 3456
#define XB_SPIN_CAP (1u << 18)

__device__ __forceinline__ unsigned xb_ld(unsigned* p)              { return __hip_atomic_load(p, __ATOMIC_RELAXED, __HIP_MEMORY_SCOPE_AGENT); }
__device__ __forceinline__ unsigned xb_add(unsigned* p, unsigned v) { return __hip_atomic_fetch_add(p, v, __ATOMIC_RELAXED, __HIP_MEMORY_SCOPE_AGENT); }
__device__ __forceinline__ unsigned xb_xcc_id() { return (unsigned)__builtin_amdgcn_s_getreg((3 << 11) | 20) & 0xFu; }
#define XB_SPIN(cond, bar) do { unsigned _sp = 0; while (cond) { __builtin_amdgcn_s_sleep(1); \
    if ((++_sp & 255u) == 0u) { if (xb_ld(&(bar)[XB_TMO])) break; if (_sp > XB_SPIN_CAP) { atomicAdd(&(bar)[XB_TMO], 1u); break; } } } } while (0)

struct XcdBarrier {
    unsigned* bar; unsigned x;
    volatile LAS unsigned* st;
};

__device__ __forceinline__ XcdBarrier xcd_barrier_post(unsigned* bar, volatile LAS unsigned* st) {
    XcdBarrier b; b.bar = bar; b.x = xb_xcc_id(); b.st = st;
    if (threadIdx.x == 0) (void)xb_add(&bar[XB_XCNT(b.x)], 1u);
    return b;
}
__device__ __forceinline__ void xcd_barrier_complete(unsigned* bar, unsigned x, unsigned& nloc, unsigned& nx) {
    const unsigned G = gridDim.x * gridDim.y * gridDim.z;
    unsigned sum, cnt, mine, sp = 0u;
    for (;;) {
        sum = 0u; cnt = 0u; mine = 0u;
#pragma unroll
        for (unsigned j = 0; j < 16; ++j) { const unsigned c = xb_ld(&bar[XB_XCNT(j)]); sum += c; cnt += (c > 0u) ? 1u : 0u; mine = (j == x) ? c : mine; }
        if (sum == G) break;
        __builtin_amdgcn_s_sleep(1);
        if ((++sp & 255u) == 0u) { if (xb_ld(&bar[XB_TMO])) break; if (sp > XB_SPIN_CAP) { atomicAdd(&bar[XB_TMO], 1u); break; } }
    }
    nloc = mine > 0u ? mine : 1u; nx = cnt > 0u ? cnt : 1u;
}

__device__ __forceinline__ void xcd_barrier(const XcdBarrier& b) {
    asm volatile("s_waitcnt vmcnt(0)" ::: "memory");
    __syncthreads();
    if (threadIdx.x == 0) {
        unsigned* bar = b.bar;
        __builtin_amdgcn_s_waitcnt(0);
        unsigned nloc = b.st[0], nx = b.st[1];
        if (nloc == 0u) { xcd_barrier_complete(bar, b.x, nloc, nx); b.st[0] = nloc; b.st[1] = nx; }
        const unsigned old = xb_add(&bar[XB_XSUB(b.x)], 1u);
        const unsigned gen = old / nloc;
        if (old + 1u == (gen + 1u) * nloc) {
            __builtin_amdgcn_fence(__ATOMIC_RELEASE, "agent");
            asm volatile("s_waitcnt vmcnt(0)" ::: "memory");
            const unsigned og = xb_add(&bar[XB_TOP], 1u);
            const unsigned tg = og / nx;
            if (og + 1u == (tg + 1u) * nx) xb_add(&bar[XB_TOPGEN], 1u);
            else XB_SPIN(xb_ld(&bar[XB_TOPGEN]) == tg, bar);
            __builtin_amdgcn_fence(__ATOMIC_ACQUIRE, "agent");
            xb_add(&bar[XB_XGEN(b.x)], 1u);
            asm volatile("s_waitcnt vmcnt(0)" ::: "memory");
        } else {
            XB_SPIN(xb_ld(&bar[XB_XGEN(b.x)]) == gen, bar);
            __builtin_amdgcn_fence(__ATOMIC_ACQUIRE, "agent");
            asm volatile("s_waitcnt vmcnt(0)" ::: "memory");
        }
    }
    __syncthreads();
}

struct Args { const float* in[10]; float* out; unsigned char* ws; int ph_lo, ph_hi; };
constexpr int N_PHASES = 2 + 4 * DEPTH;

__global__ void __launch_bounds__(NWAVES * 64, 2) hyb_fwd(Args args) {
    extern __shared__ __attribute__((aligned(16))) unsigned char lds[];
    LAS unsigned char* const L = (LAS unsigned char*)lds;
#define PHASE_IDS() int tid_o = threadIdx.x; asm volatile("" : "+v"(tid_o)); const int tid = tid_o, lane = tid & 63, wave = __builtin_amdgcn_readfirstlane(tid >> 6); const int gw = vcu * NWAVES + wave; (void)tid; (void)lane; (void)gw
    const int G = gridDim.x; const int bx = blockIdx.x; const int vcu = (G % 8 == 0) ? (bx % 8) * (G / 8) + bx / 8 : bx;
    const int NGW = G * NWAVES;
    unsigned char* const ws = args.ws;
    const float* x_in = args.in[0]; const float* c_in = args.in[1]; const float* w_ada = args.in[2]; const float* b_ada = args.in[3]; const float* g_norm = args.in[4];
    const float* w_in = args.in[5]; const float* b_f = args.in[6]; const float* g_grp = args.in[7]; const float* w_out = args.in[8]; const float* g_final = args.in[9];
    float* const out = args.out;
    float* const ADA = (float*)(ws + WS_ADA); float* const LOGF = (float*)(ws + WS_LOGF); float* const CUM = (float*)(ws + WS_CUM);
    bf16* const WIN = (bf16*)(ws + WS_WIN); bf16* const WOUT = (bf16*)(ws + WS_WOUT); bf16* const XN = (bf16*)(ws + WS_XN);
    bf16* const QO = (bf16*)(ws + WS_QO); bf16* const KB = (bf16*)(ws + WS_K); bf16* const VB = (bf16*)(ws + WS_V); bf16* const GB = (bf16*)(ws + WS_G); bf16* const OB = (bf16*)(ws + WS_O); unsigned* const KN = (unsigned*)(ws + WS_KN); unsigned* const QCTR = (unsigned*)(ws + WS_QCTR); float* const SSQ = (float*)(ws + WS_SSQ); bf16* const VT = (bf16*)(ws + WS_VT);
    const int lo = args.ph_lo, hi_ph = args.ph_hi;
    cg::grid_group grid = cg::this_grid();
    for (int u = threadIdx.x; u < (LDS_BYTES - RING_BYTES) / 4; u += NWAVES * 64) ((LAS unsigned*)(L + RING_BYTES))[u] = 0u;
    __syncthreads();
    XcdBarrier bar = xcd_barrier_post((unsigned*)(ws + WS_BAR), (volatile LAS unsigned*)(L + BARST_OFF));
    if (lo < 0) grid.sync();
#define IN(k) (lo <= (k) && (k) < hi_ph)
#define SEAM(k) do { if (IN(k) && IN((k) + 1)) xcd_barrier(bar); } while (0)

    if (IN(0)) { PHASE_IDS();
        LAS float* scr = (LAS float*)(L + wave * 16384);
        constexpr int I_IN = (D / 64) * (NPROJ / 32), I_OUT = (D / 64) * (D / 32), I_L = I_IN + I_OUT;
        for (int it = gw; it < DEPTH * I_L; it += NGW) {
            const int l = it / I_L; int r = it % I_L;
            if (r < I_IN) { const int kb = r / (NPROJ / 32), db = r % (NPROJ / 32), seg = db >> 4;
                const int sseg = seg == 1 ? 3 : seg == 2 ? 1 : seg == 3 ? 4 : seg == 4 ? 2 : seg;
                transpose_item(w_in + (size_t)l * D * D_IN, D_IN, 64 * kb, sseg * 512 + (db & 15) * 32, WIN + (size_t)l * NPROJ * D, D, 32 * db, scr, lane); }
            else { r -= I_IN; const int kb = r / (D / 32), db = r % (D / 32);
                transpose_item(w_out + (size_t)l * D * D, D, 64 * kb, 32 * db, WOUT + (size_t)l * D * D, D, 32 * db, scr, lane); }
        }
        if (bx < DEPTH * 48) {
            const int l = bx / 48, cb = bx % 48, cl = tid & 15, kg = tid >> 4;
            const float* wp = w_ada + ((size_t)l * D + kg) * (3 * D) + cb * 64 + 4 * cl;
            f32x4 a0 = (f32x4){0.f, 0.f, 0.f, 0.f}, a1 = a0;
#pragma unroll 8
            for (int i = 0; i < 32; ++i) { const f32x4 w = *(const f32x4*)(wp + (size_t)(32 * i) * (3 * D)); const float c0 = silu_f(c_in[kg + 32 * i]), c1 = silu_f(c_in[D + kg + 32 * i]); a0 += w * c0; a1 += w * c1; }
            LAS f32x4* red = (LAS f32x4*)L;
            __syncthreads();
            red[(kg * 2 + 0) * 16 + cl] = a0; red[(kg * 2 + 1) * 16 + cl] = a1;
            __syncthreads();
            if (tid < 32) { const int b = tid >> 4, c2 = tid & 15; f32x4 s = *(const f32x4*)(b_ada + (size_t)l * 3 * D + cb * 64 + 4 * c2);
                for (int k2 = 0; k2 < 32; ++k2) s += red[(k2 * 2 + b) * 16 + c2];
                *(f32x4*)(ADA + ((size_t)l * 2 + b) * 3 * D + cb * 64 + 4 * c2) = s; }
            __syncthreads();
        }
    }
    SEAM(0);

    for (int l = 0; l < DEPTH; ++l) {
        const int pb = 1 + 4 * l;
        const float* xsrc = (l == 0) ? x_in : out;
        const float* ada = ADA + (size_t)l * 2 * 3 * D;
        if (IN(pb)) { PHASE_IDS();
            const float* wf = w_in + (size_t)l * D * D_IN + NPROJ;
            f32x4 wfa[4][4][2], gv[4];
#pragma unroll
            for (int j = 0; j < 4; ++j) { gv[j] = *(const f32x4*)(g_norm + l * D + 4 * lane + 256 * j);
#pragma unroll
                for (int c = 0; c < 4; ++c) { const float* p = wf + (size_t)(4 * lane + 256 * j + c) * D_IN; wfa[j][c][0] = *(const f32x4*)p; wfa[j][c][1] = *(const f32x4*)(p + 4); } }
            const float bfl = (lane < 8) ? b_f[l * 8 + lane] : 0.f;
            f32x4 v[4];
#pragma unroll
            for (int j = 0; j < 4; ++j) v[j] = *(const f32x4*)(xsrc + (size_t)gw * D + 4 * lane + 256 * j);
            for (int m = gw; m < M; m += NGW) {
                const float* ab = ada + (size_t)(m / T) * 3 * D;
                f32x4 vn[4]; const int mn = (m + NGW < M) ? m + NGW : m;
#pragma unroll
                for (int j = 0; j < 4; ++j) vn[j] = *(const f32x4*)(xsrc + (size_t)mn * D + 4 * lane + 256 * j);
                float ss = 0.f;
#pragma unroll
                for (int j = 0; j < 4; ++j) ss += (v[j].x * v[j].x + v[j].y * v[j].y) + (v[j].z * v[j].z + v[j].w * v[j].w);
                const float rstd = 1.0f / sqrtf(wave_sum(ss) * (1.f / D) + EPS);
                float f[8];
#pragma unroll
                for (int k = 0; k < 8; ++k) f[k] = 0.f;
#pragma unroll
                for (int j = 0; j < 4; ++j) { const f32x4 sh = *(const f32x4*)(ab + 4 * lane + 256 * j), sc = *(const f32x4*)(ab + D + 4 * lane + 256 * j);
                    const f32x4 hh = (v[j] * rstd) * gv[j] * (sc + 1.0f) + sh;
                    *(unsigned long long*)(XN + (size_t)m * D + 4 * lane + 256 * j) = (unsigned long long)pk2(hh.x, hh.y) | ((unsigned long long)pk2(hh.z, hh.w) << 32);
#pragma unroll
                    for (int c = 0; c < 4; ++c) {
#pragma unroll
                        for (int k = 0; k < 4; ++k) { f[k] += hh[c] * wfa[j][c][0][k]; f[4 + k] += hh[c] * wfa[j][c][1][k]; } } }
#pragma unroll
                for (int k = 0; k < 8; ++k) f[k] = wave_sum(f[k]);
                float fv = f[0];
#pragma unroll
                for (int k = 1; k < 8; ++k) fv = (lane == k) ? f[k] : fv;
                if (lane < 8) { const float tt = -(fv + bfl) * LOG2E;
                    const float lf = (tt > 30.f) ? -tt : -__builtin_amdgcn_logf(1.0f + __builtin_amdgcn_exp2f(tt));
                    LOGF[(size_t)m * 8 + lane] = lf; }
#pragma unroll
                for (int j = 0; j < 4; ++j) v[j] = vn[j];
            }
        }
        SEAM(pb);
        if (IN(pb + 1)) {
            if (bx < BATCH * 8) { PHASE_IDS();
                const int b = bx >> 3, h8 = bx & 7; LAS float* wt = (LAS float*)(L + MISC_OFF);
                float pv[16]; float run = 0.f;
#pragma unroll
                for (int i = 0; i < 16; ++i) { run += LOGF[((size_t)b * T + 16 * tid + i) * 8 + h8]; pv[i] = run; }
                float inc = run;
#pragma unroll
                for (int o = 1; o < 64; o <<= 1) { const float t = __shfl_up(inc, o); if (lane >= o) inc += t; }
                if (lane == 63) wt[wave] = inc;
                __syncthreads();
                float off = inc - run;
                for (int w = 0; w < wave; ++w) off += wt[w];
#pragma unroll
                for (int i = 0; i < 16; ++i) CUM[(size_t)bx * T + 16 * tid + i] = off + pv[i];
                __syncthreads();
            }
            pg8::Gemm g{XN, WIN + (size_t)l * NPROJ * D, M, NPROJ, D}; pg8::StaticOrder S; S.init(M, NPROJ, G, bx);
            pg8::EpiBf16<0> E{VT, 2, 512, KN + (size_t)l * 16 * 128 * 2, 1, 512, T, QO, D, nullptr, D, (size_t)(WS_K - WS_QO) / 2, attn_body::C2};
            pg8::gemm_phase<pg8::EpiBf16<0>, pg8::StaticOrder, PG8_ALIGN, PG8_SP2>(L, g, S, E);
        }
        SEAM(pb + 1);
        if (IN(pb + 2)) {
            const attn_body::bf16* Qp = (const attn_body::bf16*)QO; const attn_body::bf16* Kp = (const attn_body::bf16*)KB; const attn_body::bf16* Vp = (const attn_body::bf16*)VB;
            const float* ggl = g_grp + (size_t)l * D;
            volatile LAS unsigned* const qw = (volatile LAS unsigned*)(L + MISC_OFF + 32);
            const int xq0 = bx & 7; bool own = true;
            for (;;) {
                __syncthreads();
                if (threadIdx.x < 64) { const int ln = threadIdx.x; unsigned idx = 0xffffffffu; int qsel = xq0;
                    if (own) { unsigned r = 0u; if (ln == 0) r = atomicAdd(QCTR + (size_t)(l * 8 + xq0) * 64, 1u); r = (unsigned)__builtin_amdgcn_readfirstlane((int)r); if (r < 128u) idx = r; else own = false; }
                    if (!own && idx == 0xffffffffu) {
                        for (;;) {
                            const unsigned c = (ln < 8) ? __hip_atomic_load(QCTR + (size_t)(l * 8 + ln) * 64, __ATOMIC_RELAXED, __HIP_MEMORY_SCOPE_AGENT) : 128u;
                            const unsigned a8 = (unsigned)__ballot(c < 128u) & 0xffu;
                            if (!a8) break;
                            const unsigned rot = ((a8 >> xq0) | (a8 << (8 - xq0))) & 0xffu; const int q = (xq0 + __builtin_ctz(rot)) & 7;
                            unsigned r = 0u; if (ln == 0) r = atomicAdd(QCTR + (size_t)(l * 8 + q) * 64, 1u); r = (unsigned)__builtin_amdgcn_readfirstlane((int)r);
                            if (r < 128u) { idx = r; qsel = q; break; }
                        } }
                    if (ln == 0) { qw[0] = idx; qw[1] = (unsigned)qsel; } }
                __syncthreads();
                const unsigned idx = qw[0]; const int xq = (int)qw[1], qb_ = xq >> 2, pr = xq & 3;
                if (idx >= 128u) break;
                if (idx < 64u) { const int h8 = (idx & 1u) ? pr : 7 - pr, qb = 31 - (int)(idx >> 1), bh = qb_ * 8 + h8;
                    attn_body::attn_unit<8>(qb_, 8 + h8, qb, Qp, Kp, Vp, (attn_body::bf16*)OB, CUM + (size_t)bh * T, KN + ((size_t)l * 16 + bh) * 256, (const attn_body::bf16*)GB, ggl, SSQ, (char*)lds); }
                else { const unsigned j2 = idx - 64u; attn_body::sb_unit(qb_, 2 * pr + (int)(j2 & 1u), 31 - (int)(j2 >> 1), Qp, Kp, (const attn_body::bf16*)VT, (attn_body::bf16*)OB, (const attn_body::bf16*)GB, ggl, SSQ); }
            }
        }
        SEAM(pb + 2);
        if (IN(pb + 3)) {
            pg8::Gemm g{OB, WOUT + (size_t)l * D * D, M, D, D}; pg8::StaticOrder S; S.init(M, D, G, bx);
            pg8::EpiRes E{xsrc, out, D, ada + 2 * D, T, 3 * D, SSQ, EPS};
            pg8::gemm_phase<pg8::EpiRes, pg8::StaticOrder, PG8_ALIGN, PG8_SP2>(L, g, S, E);
        }
        SEAM(pb + 3);
    }
    if (IN(N_PHASES - 1)) { PHASE_IDS();
        f32x4 gv[4];
#pragma unroll
        for (int j = 0; j < 4; ++j) gv[j] = *(const f32x4*)(g_final + 4 * lane + 256 * j);
        for (int m = gw; m < M; m += NGW) {
            f32x4 v[4]; float ss = 0.f;
#pragma unroll
            for (int j = 0; j < 4; ++j) { v[j] = *(const f32x4*)(out + (size_t)m * D + 4 * lane + 256 * j); ss += (v[j].x * v[j].x + v[j].y * v[j].y) + (v[j].z * v[j].z + v[j].w * v[j].w); }
            const float rstd = 1.0f / sqrtf(wave_sum(ss) * (1.f / D) + EPS);
#pragma unroll
            for (int j = 0; j < 4; ++j) *(f32x4*)(out + (size_t)m * D + 4 * lane + 256 * j) = (v[j] * rstd) * gv[j];
        }
    }
#undef IN
#undef SEAM
}

extern "C" void kernel_launch(void* const* d_in, const int* in_sizes, int n_in, void* d_out, int out_size, void* d_ws, size_t ws_size, hipStream_t stream) {
    static int grid = 0;
    if (grid == 0) {
        if (n_in != 10 || in_sizes[0] != M * D || out_size != M * D || ws_size < WS_END) { fprintf(stderr, "kernel_launch: unexpected shapes (n_in %d, in0 %d, out %d, ws %zu)\n", n_in, n_in > 0 ? in_sizes[0] : -1, out_size, ws_size); grid = -1; return; }
        int dev = 0, cus = 0, per_cu = 0;
        if (hipGetDevice(&dev) != hipSuccess || hipDeviceGetAttribute(&cus, hipDeviceAttributeMultiprocessorCount, dev) != hipSuccess) { grid = -1; return; }
        if (hipFuncSetAttribute((const void*)hyb_fwd, hipFuncAttributeMaxDynamicSharedMemorySize, LDS_BYTES) != hipSuccess) { fprintf(stderr, "kernel_launch: hipFuncSetAttribute failed\n"); grid = -1; return; }
        if (hipOccupancyMaxActiveBlocksPerMultiprocessor(&per_cu, (const void*)hyb_fwd, NWAVES * 64, LDS_BYTES) != hipSuccess || per_cu < 1) { fprintf(stderr, "kernel_launch: occupancy query says %d\n", per_cu); per_cu = 1; }
        (void)hipGetLastError();
        grid = cus * 1;
    }
    if (grid < 0) return;
    if (hipMemsetAsync((char*)d_ws + WS_CTL, 0, CTL_ZERO_BYTES, stream) != hipSuccess) { fprintf(stderr, "kernel_launch: memset failed\n"); return; }
    Args a{};
    for (int i = 0; i < 10; ++i) a.in[i] = (const float*)d_in[i];
    a.out = (float*)d_out; a.ws = (unsigned char*)d_ws;
#if MK_PER_PHASE
    for (int p = 0; p < N_PHASES; ++p) { a.ph_lo = p; a.ph_hi = p + 1; void* kargs[] = {&a};
        hipError_t e = hipLaunchCooperativeKernel((const void*)hyb_fwd, dim3(grid), dim3(NWAVES * 64), kargs, LDS_BYTES, stream);
        if (e != hipSuccess) { fprintf(stderr, "kernel_launch: launch of phase %d failed: %s\n", p, hipGetErrorString(e)); break; } }
#else
    a.ph_lo = 0; a.ph_hi = N_PHASES; void* kargs[] = {&a};
    hipError_t e = hipLaunchCooperativeKernel((const void*)hyb_fwd, dim3(grid), dim3(NWAVES * 64), kargs, LDS_BYTES, stream);
    if (e != hipSuccess) fprintf(stderr, "kernel_launch: cooperative launch failed: %s (grid %d)\n", hipGetErrorString(e), grid);
#endif
}
```

```cpp
#include <hip/hip_runtime.h>
#include <hip/hip_cooperative_groups.h>
#include <cstdio>
#include <cstdint>
namespace cg = cooperative_groups;
namespace pg8 {
#define PG8_LAS __attribute__((address_space(3)))
typedef unsigned short bf16_t;
typedef short bf16x8 __attribute__((ext_vector_type(8)));
typedef float f32x4 __attribute__((ext_vector_type(4)));
typedef unsigned u32x4 __attribute__((ext_vector_type(4)));
constexpr int BM = 256, BK = 64, HALF = 128, HTB = HALF * BK * 2  , STAGE_BYTES = 8 * HTB, NXCD = 8, WGM = 8;

__host__ __device__ __forceinline__ int lds_byte(int r, int c) { const int st = (r >> 4) * 2 + (c >> 5), rr = r & 15, cc = c & 31, ob = rr * 64 + cc * 2; return st * 1024 + (ob ^ (((ob >> 9) & 1) << 5)); }
__host__ __device__ __forceinline__ void stage_rc(int b, int& R, int& C) { const int st = b / 1024, sb = b % 1024, swz = sb ^ (((sb >> 9) & 1) << 5); R = (st >> 1) * 16 + swz / 64; C = (st & 1) * 32 + (swz % 64) / 2; }
__host__ __device__ __forceinline__ int perm32(int rho) { const int n = rho >> 4, i = rho & 15; return 8 * (i >> 2) + 4 * n + (i & 3); }

struct Unit { int pm, pn; };
struct Gemm { const bf16_t* A; const bf16_t* Bt; int M, N, K; };

struct StaticOrder {
    int nM, nN, nwg, G, c;
    __host__ __device__ void init(int M, int N, int G_, int c_) { nM = M / BM; nN = N / BM; nwg = nM * nN; G = G_; c = c_; }
    __host__ __device__ bool next(int i, Unit& u) const {
        const long L = (long)i * G + c; if (L >= nwg) return false;
        int wgid = (int)L; { const int q = nwg / NXCD, r = nwg % NXCD, xcd = wgid % NXCD, off = wgid / NXCD; wgid = (xcd < r ? xcd * (q + 1) : r * (q + 1) + (xcd - r) * q) + off; }
        const int nig = WGM * nN, gid = wgid / nig, fm = gid * WGM, gsz = (nM - fm) < WGM ? (nM - fm) : WGM;
        u.pm = fm + ((wgid % nig) % gsz); u.pn = (wgid % nig) / gsz; return true;
    }
    __device__ __forceinline__ void a_ready(const Unit&) const {}
    __device__ __forceinline__ void done(const Unit&) const {}
};

__device__ __forceinline__ unsigned cvt_pk_bf16(float lo, float hi) { unsigned r; asm volatile("v_cvt_pk_bf16_f32 %0, %1, %2" : "=v"(r) : "v"(lo), "v"(hi)); return r; }
typedef float f32x2 __attribute__((ext_vector_type(2)));
__device__ __forceinline__ f32x2 gelu_pk(f32x2 v) {
    const f32x2 av = __builtin_elementwise_abs(v), d = av * 0.2316418882f + 1.0f;
    f32x2 t; t.x = __builtin_amdgcn_rcpf(d.x); t.y = __builtin_amdgcn_rcpf(d.y);
    f32x2 q = t * 0.5307027145f + (-0.7265760135f); q = q * t + 0.7107068705f; q = q * t + (-0.142248368f); q = q * t + 0.127414796f; q = q * t;
    const f32x2 s = (v * v) * (-0.72134752044f);
    f32x2 e; e.x = __builtin_amdgcn_exp2f(s.x); e.y = __builtin_amdgcn_exp2f(s.y);
    const f32x2 m = v * (q * e), r = v - m;
    f32x2 o; o.x = v.x < 0.f ? m.x : r.x; o.y = v.y < 0.f ? m.y : r.y; return o;
}

template <int ACT  > struct EpiBf16 {
    static constexpr bool PERM = true, AFTER_DRAIN = false, MID = false; static_assert(ACT == 0 || ACT == 1, "EpiBf16: ACT is 0 (none) or 1 (gelu_pk)");
    bf16_t* vt; int vt_tile, vt_cols;
    unsigned* kn; int kn_tile, kn_col0, kn_rows;
    bf16_t* O; int ldc; const float* bias; int split_cols; size_t split_stride; float scale0;
    __device__ __forceinline__ void operator()(const f32x4 (&acc)[2][2][4][2], const Unit& u, int wr, int wc, int fr, int fq) const {
        const int row0 = u.pm * BM + wr * 64 + fr; int colt = u.pn * BM; bf16_t* base = O;
        float sc = 1.f; int tsp = 0; if (split_cols) { const int t = colt / split_cols; tsp = t; base += (size_t)t * split_stride; colt -= t * split_cols; if (t == 0) sc = scale0; }
        if (kn && tsp == kn_tile && colt >= kn_col0) {
#pragma unroll
            for (int ai = 0; ai < 2; ++ai)
#pragma unroll
                for (int bj = 0; bj < 2; ++bj) { float mx = 0.f;
#pragma unroll
                    for (int m = 0; m < 4; ++m) { const f32x4 a = acc[ai][bj][m][0], b = acc[ai][bj][m][1]; float s = (a[0] * a[0] + a[1] * a[1]) + (a[2] * a[2] + a[3] * a[3]) + (b[0] * b[0] + b[1] * b[1]) + (b[2] * b[2] + b[3] * b[3]);
                        s += __shfl_xor(s, 16); s += __shfl_xor(s, 32); mx = __builtin_fmaxf(mx, s); }
                    mx = __builtin_fmaxf(mx, __shfl_xor(mx, 1)); mx = __builtin_fmaxf(mx, __shfl_xor(mx, 2)); mx = __builtin_fmaxf(mx, __shfl_xor(mx, 4)); mx = __builtin_fmaxf(mx, __shfl_xor(mx, 8));
                    if (fr == 0 && fq == 0) { const int r0 = u.pm * BM + ai * HALF + wr * 64, bb = r0 / kn_rows, tile = (r0 % kn_rows) >> 6, h8 = (colt - kn_col0 + bj * HALF + wc * 32) >> 6;
                        atomicMax(kn + ((size_t)(bb * 8 + h8) * 128 + tile) * 2 + (wc & 1), __float_as_uint(mx)); } }
        }
        const int col0 = colt + wc * 32 + 8 * fq, bcol0 = u.pn * BM + wc * 32 + 8 * fq;
        f32x4 bv[2][2];
#pragma unroll
        for (int bj = 0; bj < 2; ++bj)
#pragma unroll
            for (int n = 0; n < 2; ++n) bv[bj][n] = bias ? *(const f32x4*)(bias + bcol0 + bj * HALF + 4 * n) : (f32x4){0.f, 0.f, 0.f, 0.f};
#pragma unroll
        for (int ai = 0; ai < 2; ++ai)
#pragma unroll
            for (int m = 0; m < 4; ++m) { bf16_t* rowp = base + (size_t)(row0 + ai * HALF + m * 16) * ldc + col0;
#pragma unroll
                for (int bj = 0; bj < 2; ++bj) { f32x4 v0 = acc[ai][bj][m][0] + bv[bj][0], v1 = acc[ai][bj][m][1] + bv[bj][1];
                    if (ACT == 1) { f32x2 a = gelu_pk((f32x2){v0[0], v0[1]}), b = gelu_pk((f32x2){v0[2], v0[3]}), c = gelu_pk((f32x2){v1[0], v1[1]}), d = gelu_pk((f32x2){v1[2], v1[3]});
                        v0 = (f32x4){a.x, a.y, b.x, b.y}; v1 = (f32x4){c.x, c.y, d.x, d.y}; }
                    v0 = v0 * sc; v1 = v1 * sc; u32x4 w; w.x = cvt_pk_bf16(v0[0], v0[1]); w.y = cvt_pk_bf16(v0[2], v0[3]); w.z = cvt_pk_bf16(v1[0], v1[1]); w.w = cvt_pk_bf16(v1[2], v1[3]);
                    *(u32x4*)(rowp + bj * HALF) = w;
                    if (vt && tsp == vt_tile && colt < vt_cols) { const int row = row0 + ai * HALF + m * 16, c0 = col0 + bj * HALF; bf16_t* tp = vt + ((size_t)((row / kn_rows) * 8 + (c0 >> 6)) * 64 + (c0 & 63)) * kn_rows + (row % kn_rows);
#pragma unroll
                        for (int j = 0; j < 4; ++j) { tp[(size_t)(2 * j) * kn_rows] = (bf16_t)(w[j] & 0xffffu); tp[(size_t)(2 * j + 1) * kn_rows] = (bf16_t)(w[j] >> 16); } } } }
    }
};
struct EpiRes {
    static constexpr bool PERM = false, AFTER_DRAIN = false, MID = true;
    const float* base; float* out; int ldc; const float* gate; int rows_per_batch; int ldg; const float* ssq; float eps;
    __device__ __forceinline__ void group_ms(int row, float& m0, float& m1) const {
        const f32x4* p = (const f32x4*)(ssq + (size_t)row * 16); const f32x4 a = p[0], b = p[1], c = p[2], d = p[3];
        m0 = (((a[0] + a[1]) + (a[2] + a[3])) + ((b[0] + b[1]) + (b[2] + b[3]))) * (1.f / 512.f) + eps;
        m1 = (((c[0] + c[1]) + (c[2] + c[3])) + ((d[0] + d[1]) + (d[2] + d[3]))) * (1.f / 512.f) + eps; }
    __device__ __forceinline__ void mid(f32x4 (&acc)[2][2][4][2], const Unit& u, int wr, int fr) const {
#pragma unroll
        for (int ai = 0; ai < 2; ++ai)
#pragma unroll
            for (int m = 0; m < 4; ++m) { float m0, m1; group_ms(u.pm * BM + ai * HALF + wr * 64 + m * 16 + fr, m0, m1); const float ratio = sqrtf(m1 / m0);
#pragma unroll
                for (int bj = 0; bj < 2; ++bj)
#pragma unroll
                    for (int n = 0; n < 2; ++n) acc[ai][bj][m][n] = acc[ai][bj][m][n] * ratio; }
    }
    __device__ __forceinline__ void operator()(const f32x4 (&acc)[2][2][4][2], const Unit& u, int wr, int wc, int fr, int fq) const {
        const int col0 = u.pn * BM + wc * 32 + 4 * fq;
        const float* gp = gate + (size_t)((u.pm * BM) / rows_per_batch) * ldg + col0;
        f32x4 gv[2][2];
#pragma unroll
        for (int bj = 0; bj < 2; ++bj)
#pragma unroll
            for (int n = 0; n < 2; ++n) gv[bj][n] = *(const f32x4*)(gp + bj * HALF + n * 16) + 1.0f;
#pragma unroll
        for (int ai = 0; ai < 2; ++ai)
#pragma unroll
            for (int m = 0; m < 4; ++m) { const int row = u.pm * BM + ai * HALF + wr * 64 + m * 16 + fr; const size_t off = (size_t)row * ldc + col0;
                float m0, m1; group_ms(row, m0, m1); const float rfx = 1.0f / sqrtf(m1);
#pragma unroll
                for (int bj = 0; bj < 2; ++bj)
#pragma unroll
                    for (int n = 0; n < 2; ++n) { const f32x4 bs = *(const f32x4*)(base + off + bj * HALF + n * 16);
                        *(f32x4*)(out + off + bj * HALF + n * 16) = bs + gv[bj][n] * (acc[ai][bj][m][n] * rfx); }
                if (m & 1) asm volatile("" ::: "memory"); }
    }
};

template <class Epi, class Sched, bool ALIGN_EPI = false, bool SP2 = false>
__device__ __forceinline__ void gemm_phase(PG8_LAS unsigned char* lds, const Gemm g, const Sched& S, const Epi& E) {
    int tid_o = threadIdx.x; asm volatile("" : "+v"(tid_o));
    const int tid = tid_o, wid = __builtin_amdgcn_readfirstlane(tid >> 6), lane = tid & 63, wr = wid >> 2, wc = wid & 3, fr = lane & 15, fq = lane >> 4;
    const int K = g.K, nt = K / BK;
    unsigned voffA[2], voffB[2];
#pragma unroll
    for (int i = 0; i < 2; ++i) { int R, C; stage_rc(tid * 16 + i * 8192, R, C); const int Rb = Epi::PERM ? ((R & ~31) + perm32(R & 31)) : R;
        voffA[i] = (unsigned)(R * K + C) * 2u; voffB[i] = (unsigned)(Rb * K + C) * 2u; }
    const size_t kstep = (size_t)(BK * 2);
    const size_t hstep = (size_t)HALF * K * 2;
    const size_t tstep = 2 * hstep;
    const unsigned ldsw = (unsigned)wid * 1024u;
    const int aoff = lds_byte(wr * 64 + fr, fq * 8), boff = lds_byte(wc * 32 + fr, fq * 8);
#define PG8_SA(b, h) (((b) * 2 + (h)) * HTB)
#define PG8_SB(b, h) ((4 + (b) * 2 + (h)) * HTB)
#define PG8_STAGE(bufoff, gbase, voff) do { _Pragma("unroll") for (int _i = 0; _i < 2; ++_i) \
        __builtin_amdgcn_global_load_lds((const unsigned*)((const char*)(gbase) + (voff)[_i]), (PG8_LAS unsigned*)(lds + (bufoff) + ldsw + _i * 8192), 16, 0, 0); } while (0)
#define PG8_LDA(dst, b, h) do { _Pragma("unroll") for (int m = 0; m < 4; ++m) _Pragma("unroll") for (int k = 0; k < 2; ++k) dst[m][k] = *(const PG8_LAS bf16x8*)(lds + PG8_SA(b, h) + aoff + m * 2048 + k * 1024); } while (0)
#define PG8_LDB(dst, b, h) do { _Pragma("unroll") for (int n = 0; n < 2; ++n) _Pragma("unroll") for (int k = 0; k < 2; ++k) dst[n][k] = *(const PG8_LAS bf16x8*)(lds + PG8_SB(b, h) + boff + n * 2048 + k * 1024); } while (0)
#define PG8_MMA(ai, bj, At, Bt) do { __builtin_amdgcn_s_setprio(1); _Pragma("unroll") for (int m = 0; m < 4; ++m) _Pragma("unroll") for (int n = 0; n < 2; ++n) _Pragma("unroll") for (int k = 0; k < 2; ++k) \
        acc[ai][bj][m][n] = __builtin_amdgcn_mfma_f32_16x16x32_bf16(Bt[n][k], At[m][k], acc[ai][bj][m][n], 0, 0, 0); __builtin_amdgcn_s_setprio(0); } while (0)
#define PG8_WAIT_V(n) asm volatile("s_waitcnt vmcnt(" #n ")" ::: "memory")
#define PG8_WAIT_L(n) asm volatile("s_waitcnt lgkmcnt(" #n ")" ::: "memory")
#define PG8_BAR __builtin_amdgcn_s_barrier()
#define PG8_SCHED __builtin_amdgcn_sched_barrier(0)
    Unit cur, nxt; int ui = 0;
    if (!S.next(0, cur)) return;
    f32x4 acc[2][2][4][2];
#pragma unroll
    for (int a = 0; a < 2; ++a)
#pragma unroll
        for (int b = 0; b < 2; ++b)
#pragma unroll
            for (int m = 0; m < 4; ++m)
#pragma unroll
                for (int n = 0; n < 2; ++n) acc[a][b][m][n] = (f32x4){0.f, 0.f, 0.f, 0.f};
    bf16x8 At[4][2], B0[2][2], B1[2][2];
    const char* cA = (const char*)g.A + (size_t)cur.pm * tstep; const char* cB = (const char*)g.Bt + (size_t)cur.pn * tstep;
    S.a_ready(cur);
    if constexpr (SP2) {
        PG8_STAGE(PG8_SB(0, 0), cB, voffB); PG8_STAGE(PG8_SB(0, 1), cB + hstep, voffB); PG8_STAGE(PG8_SA(0, 0), cA, voffA); PG8_STAGE(PG8_SA(0, 1), cA + hstep, voffA);
        if (wr == 1) PG8_BAR;
        PG8_WAIT_V(2); PG8_BAR;
        PG8_STAGE(PG8_SB(1, 0), cB + kstep, voffB); PG8_STAGE(PG8_SA(1, 0), cA + kstep, voffA); PG8_STAGE(PG8_SB(1, 1), cB + hstep + kstep, voffB);
        PG8_WAIT_V(6); PG8_BAR;
    } else {
        PG8_STAGE(PG8_SB(0, 0), cB, voffB); PG8_STAGE(PG8_SA(0, 0), cA, voffA); PG8_STAGE(PG8_SB(0, 1), cB + hstep, voffB); PG8_STAGE(PG8_SA(0, 1), cA + hstep, voffA);
        if (wr == 1) PG8_BAR;
        PG8_WAIT_V(4); PG8_BAR;
        PG8_STAGE(PG8_SB(1, 0), cB + kstep, voffB); PG8_STAGE(PG8_SA(1, 0), cA + kstep, voffA); PG8_STAGE(PG8_SB(1, 1), cB + hstep + kstep, voffB);
        PG8_WAIT_V(6); PG8_BAR;
    }
    for (;;) {
        const bool has_next = S.next(ui + 1, nxt);
        const char* nA = has_next ? (const char*)g.A + (size_t)nxt.pm * tstep : cA; const char* nB = has_next ? (const char*)g.Bt + (size_t)nxt.pn * tstep : cB;
        for (int t = 0; t < nt; t += 2) {
            if constexpr (Epi::MID) { if (t == nt / 2) E.mid(acc, cur, wr, fr); }
            const bool last = (t == nt - 2);
            const char* a1 = cA + (size_t)(t + 1) * kstep;
            const char* a2 = last ? nA : cA + (size_t)(t + 2) * kstep; const char* b2 = last ? nB : cB + (size_t)(t + 2) * kstep;
            const char* a3 = a2 + kstep; const char* b3 = b2 + kstep;
            if (last && has_next) S.a_ready(nxt);
            if constexpr (SP2) {
            PG8_LDB(B0, 0, 0); PG8_LDB(B1, 0, 1); PG8_SCHED; PG8_LDA(At, 0, 0); PG8_STAGE(PG8_SA(1, 1), a1 + hstep, voffA);
            PG8_WAIT_V(8); PG8_WAIT_L(0); PG8_BAR; PG8_MMA(0, 0, At, B0); PG8_MMA(0, 1, At, B1); PG8_BAR; PG8_SCHED;
            PG8_LDA(At, 0, 1); PG8_STAGE(PG8_SB(0, 0), b2, voffB); PG8_STAGE(PG8_SB(0, 1), b2 + hstep, voffB); PG8_STAGE(PG8_SA(0, 0), a2, voffA);
            PG8_WAIT_V(8); PG8_WAIT_L(0); PG8_BAR; PG8_MMA(1, 0, At, B0); PG8_MMA(1, 1, At, B1); PG8_BAR; PG8_SCHED;
            PG8_LDB(B0, 1, 0); PG8_LDB(B1, 1, 1); PG8_SCHED; PG8_LDA(At, 1, 0); PG8_STAGE(PG8_SA(0, 1), a2 + hstep, voffA);
            PG8_WAIT_V(8); PG8_WAIT_L(0); PG8_BAR; PG8_MMA(0, 0, At, B0); PG8_MMA(0, 1, At, B1); PG8_BAR; PG8_SCHED;
            PG8_LDA(At, 1, 1); PG8_STAGE(PG8_SB(1, 0), b3, voffB); PG8_STAGE(PG8_SB(1, 1), b3 + hstep, voffB); PG8_STAGE(PG8_SA(1, 0), a3, voffA);
            PG8_WAIT_V(8); PG8_WAIT_L(0); PG8_BAR; PG8_MMA(1, 0, At, B0); PG8_MMA(1, 1, At, B1); PG8_BAR; PG8_SCHED;
            } else {
            PG8_LDB(B0, 0, 0); PG8_SCHED; PG8_LDA(At, 0, 0); PG8_STAGE(PG8_SA(1, 1), a1 + hstep, voffA);
            PG8_WAIT_L(8); PG8_BAR; PG8_WAIT_L(0); PG8_MMA(0, 0, At, B0); PG8_BAR; PG8_SCHED;
            PG8_LDB(B1, 0, 1); PG8_STAGE(PG8_SB(0, 0), b2, voffB);
            PG8_BAR; PG8_WAIT_L(0); PG8_MMA(0, 1, At, B1); PG8_BAR;
            PG8_LDA(At, 0, 1); PG8_STAGE(PG8_SA(0, 0), a2, voffA);
            PG8_BAR; PG8_WAIT_L(0); PG8_MMA(1, 0, At, B0); PG8_BAR; PG8_SCHED;
            PG8_STAGE(PG8_SB(0, 1), b2 + hstep, voffB);
            PG8_WAIT_V(6); PG8_BAR; PG8_MMA(1, 1, At, B1); PG8_BAR;
            PG8_LDB(B0, 1, 0); PG8_SCHED; PG8_LDA(At, 1, 0); PG8_STAGE(PG8_SA(0, 1), a2 + hstep, voffA);
            PG8_WAIT_L(8); PG8_BAR; PG8_WAIT_L(0); PG8_MMA(0, 0, At, B0); PG8_BAR; PG8_SCHED;
            PG8_LDB(B1, 1, 1); PG8_STAGE(PG8_SB(1, 0), b3, voffB);
            PG8_BAR; PG8_WAIT_L(0); PG8_MMA(0, 1, At, B1); PG8_BAR;
            PG8_LDA(At, 1, 1); PG8_STAGE(PG8_SA(1, 0), a3, voffA);
            PG8_BAR; PG8_WAIT_L(0); PG8_MMA(1, 0, At, B0); PG8_BAR; PG8_SCHED;
            PG8_STAGE(PG8_SB(1, 1), b3 + hstep, voffB);
            PG8_WAIT_V(6); PG8_BAR; PG8_MMA(1, 1, At, B1); PG8_BAR;
            }
        }
        if constexpr (ALIGN_EPI) { if (wr == 0) PG8_BAR; }
        if constexpr (!Epi::AFTER_DRAIN) { E(acc, cur, wr, wc, fr, fq); S.done(cur); }
        if (!has_next) break;
#pragma unroll
        for (int a = 0; a < 2; ++a)
#pragma unroll
            for (int b = 0; b < 2; ++b)
#pragma unroll
                for (int m = 0; m < 4; ++m)
#pragma unroll
                    for (int n = 0; n < 2; ++n) acc[a][b][m][n] = (f32x4){0.f, 0.f, 0.f, 0.f};
        cur = nxt; cA = nA; cB = nB; ++ui;
        if constexpr (ALIGN_EPI) { if (wr == 1) PG8_BAR; }
    }
    PG8_WAIT_V(0);
    if constexpr (!ALIGN_EPI) { if (wr == 0) PG8_BAR; }
    PG8_BAR;
    if constexpr (Epi::AFTER_DRAIN) { E.fused(acc, cur, wr, wc, fr, fq, lds, wid, lane); S.done(cur); }
#undef PG8_SA
#undef PG8_SB
#undef PG8_STAGE
#undef PG8_LDA
#undef PG8_LDB
#undef PG8_MMA
#undef PG8_WAIT_V
#undef PG8_WAIT_L
#undef PG8_BAR
#undef PG8_SCHED
}
}

#ifndef PG8_SP2
#define PG8_SP2 true
#endif
#ifndef PG8_ALIGN
#define PG8_ALIGN true
#endif
#include <hip/hip_bf16.h>
#include <cmath>
namespace attn_body {
using bf16=__hip_bfloat16;
using bf16x8=__attribute__((ext_vector_type(8)))short;
using s16x4=__attribute__((ext_vector_type(4)))short;
using f32x16=__attribute__((ext_vector_type(16)))float;
using u32x4=__attribute__((ext_vector_type(4)))unsigned;
using f32x4v=__attribute__((ext_vector_type(4)))float;
constexpr int BATCH=2,NHEAD=16,SEQ=8192,D=64,DM=NHEAD*D;
constexpr int NW=8,QBLK=32,QB=QBLK*NW,KVBLK=64,NQB=SEQ/QB;
constexpr int ATTN_PITCH=DM, ATTN_UNIT_ROWS=QB;
__device__ __forceinline__ int crow(int r,int hi){return (r&3)+8*(r>>2)+4*hi;}
#define SBAR() __builtin_amdgcn_sched_barrier(0)
__device__ __forceinline__ void cmask(f32x16&p0,f32x16&p1,int jb,int qrel,int hi){
  const float NEG=-INFINITY; int kb=64*jb+4*hi;
  #pragma unroll
  for(int r=0;r<16;++r){int kv=kb+(r&3)+8*(r>>2); if(kv>qrel)p0[r]=NEG; if(kv+32>qrel)p1[r]=NEG;}
}

constexpr int NSLOT=3, SLOTB=8192;
constexpr int LDS_K=0, LDS_V=NSLOT*SLOTB, LDS_WS=2*NSLOT*SLOTB, LDS_OST=LDS_WS+NW*64*4, LDS_BIAS=LDS_OST+NW*4096, LDS_BYTES=LDS_BIAS+SEQ*4+256+1024;
constexpr float C2=0.125f*1.4426950408889634f;
__device__ __forceinline__ void glds16(const void*gsrc,unsigned lds_dst){unsigned keep;
  asm volatile("s_mov_b32 %0, m0\n\ts_mov_b32 m0, %2\n\ts_nop 0\n\tglobal_load_lds_dwordx4 %1, off\n\ts_mov_b32 m0, %0":"=&s"(keep):"v"(gsrc),"s"(lds_dst):"memory");}
__device__ __forceinline__ float max3f(float a,float b,float c){float r;asm("v_max3_f32 %0, %1, %2, %3":"=v"(r):"v"(a),"v"(b),"v"(c));return r;}
__device__ __forceinline__ float max2f(float a,float b){float r;asm("v_max_f32_e32 %0, %1, %2":"=v"(r):"v"(a),"v"(b));return r;}
__device__ __forceinline__ float fadd_s(float a,float b){float r;asm("v_add_f32_e32 %0, %1, %2":"=v"(r):"v"(a),"v"(b));return r;}
__device__ __forceinline__ float fsub_s(float a,float b){float r;asm("v_sub_f32_e32 %0, %1, %2":"=v"(r):"v"(a),"v"(b));return r;}
typedef float f32x2_t __attribute__((ext_vector_type(2))); typedef __bf16 bf16x2_t __attribute__((ext_vector_type(2)));
__device__ __forceinline__ unsigned cvtpk_s(float lo,float hi){f32x2_t v={lo,hi};bf16x2_t b=__builtin_convertvector(v,bf16x2_t);return __builtin_bit_cast(unsigned,b);}
#define WAIT_BAR(N) asm volatile("s_waitcnt vmcnt(" #N ") lgkmcnt(0)\n\ts_barrier":::"memory")
__device__ __forceinline__ float silu2(float x){ return x*__builtin_amdgcn_rcpf(1.0f+__builtin_amdgcn_exp2f(-1.4426950408889634f*x)); }

__device__ __forceinline__ void qkt(f32x16&p0,f32x16&p1,const char*Kslot,const bf16x8*qr,int r32,int hi){
  const char*kb=Kslot+hi*1024+r32*16;
  #pragma unroll
  for(int d0=0;d0<4;++d0){
    const bf16x8 b0=*reinterpret_cast<const bf16x8*>(kb+d0*2048);
    const bf16x8 b1=*reinterpret_cast<const bf16x8*>(kb+d0*2048+512);
    {p0=__builtin_amdgcn_mfma_f32_32x32x16_bf16(b0,qr[d0],p0,0,0,0);p1=__builtin_amdgcn_mfma_f32_32x32x16_bf16(b1,qr[d0],p1,0,0,0);}}
}
typedef __attribute__((address_space(3))) const char* lds_cptr;
typedef short v4i16_t __attribute__((ext_vector_type(4)));
__device__ __forceinline__ void kload8(bf16x8*kf,lds_cptr kp){
  kf[0]=*(const __attribute__((address_space(3))) bf16x8*)(kp);      kf[1]=*(const __attribute__((address_space(3))) bf16x8*)(kp+512);
  kf[2]=*(const __attribute__((address_space(3))) bf16x8*)(kp+2048); kf[3]=*(const __attribute__((address_space(3))) bf16x8*)(kp+2560);
  kf[4]=*(const __attribute__((address_space(3))) bf16x8*)(kp+4096); kf[5]=*(const __attribute__((address_space(3))) bf16x8*)(kp+4608);
  kf[6]=*(const __attribute__((address_space(3))) bf16x8*)(kp+6144); kf[7]=*(const __attribute__((address_space(3))) bf16x8*)(kp+6656);
}
__device__ __forceinline__ void kload2(bf16x8*kf,lds_cptr kp,int j){ kf[2*j]=*(const __attribute__((address_space(3))) bf16x8*)(kp+j*2048); kf[2*j+1]=*(const __attribute__((address_space(3))) bf16x8*)(kp+j*2048+512); }
__device__ __forceinline__ s16x4 vtr(lds_cptr p){ return __builtin_bit_cast(s16x4,__builtin_amdgcn_ds_read_tr16_b64_v4i16((__attribute__((address_space(3))) v4i16_t*)p)); }
__device__ __forceinline__ float rowmax(const f32x16&p0,const f32x16&p1){
  float a=max3f(p0[0],p0[1],p1[0]),b=max3f(p0[2],p0[3],p1[1]);a=max3f(a,p1[2],p1[3]);
  #pragma unroll
  for(int r=4;r<16;r+=4){a=max3f(a,p0[r],p0[r+1]);b=max3f(b,p0[r+2],p0[r+3]);a=max3f(a,p1[r],p1[r+1]);b=max3f(b,p1[r+2],p1[r+3]);}
  const float m=max2f(a,b);
  auto rr=__builtin_amdgcn_permlane32_swap(__float_as_uint(m),__float_as_uint(m),false,false);
  return max2f(__uint_as_float(rr[0]),__uint_as_float(rr[1]));
}
__device__ __forceinline__ void pv(f32x16*o,int vb,bf16x8 pa0,bf16x8 pa1,bf16x8 pa2,bf16x8 pa3){
  #pragma unroll
  for(int d0=0;d0<2;++d0){s16x4 lo[4],hi[4];
    #pragma unroll
    for(int ks=0;ks<4;++ks){
      asm volatile("ds_read_b64_tr_b16 %0,%1 offset:%c2":"=&v"(lo[ks]):"v"(vb),"i"(d0*4096+ks*1024):"memory");
      asm volatile("ds_read_b64_tr_b16 %0,%1 offset:%c2":"=&v"(hi[ks]):"v"(vb),"i"(d0*4096+ks*1024+512):"memory");}
    asm volatile("s_waitcnt lgkmcnt(0)":::"memory");SBAR();
    #define PK(k) (bf16x8){lo[k][0],lo[k][1],lo[k][2],lo[k][3],hi[k][0],hi[k][1],hi[k][2],hi[k][3]}
    o[d0]=__builtin_amdgcn_mfma_f32_32x32x16_bf16(pa0,PK(0),o[d0],0,0,0);
    o[d0]=__builtin_amdgcn_mfma_f32_32x32x16_bf16(pa1,PK(1),o[d0],0,0,0);
    o[d0]=__builtin_amdgcn_mfma_f32_32x32x16_bf16(pa2,PK(2),o[d0],0,0,0);
    o[d0]=__builtin_amdgcn_mfma_f32_32x32x16_bf16(pa3,PK(3),o[d0],0,0,0);
    #undef PK
  }
}

#ifndef ATTN_STORE16
#define ATTN_STORE16(p,v) (*(u32x4*)(p)=(v))
#endif
template<int THRL> __device__ __forceinline__ void attn_unit(int b,int h,int qb,const bf16*Q,const bf16*__restrict__ K,const bf16*__restrict__ V,bf16*O,const float*__restrict__ cum,const unsigned*__restrict__ kn,const bf16*__restrict__ Gp,const float*__restrict__ ggrp,float*__restrict__ ssq,char*shm){
  int tid_o=threadIdx.x; asm volatile("":"+v"(tid_o)); const int tid=tid_o,lane=tid&63,r32=lane&31,hi=lane>>5; const int wid=__builtin_amdgcn_readfirstlane(tid>>6);
  const long rowbase=(long)b*SEQ; const int q0=qb*QB;
  const bf16*Qw=Q+(rowbase+q0+wid*QBLK)*DM+h*D;
  const unsigned lds0=(unsigned)(uintptr_t)shm;
  float*wsf=(float*)(shm+LDS_WS)+wid*64;
  int NT=(q0+QB)/KVBLK;
  typedef __attribute__((address_space(3))) float lds_f; typedef __attribute__((address_space(3))) f32x4v lds_f4;
  lds_f* const blp=(lds_f*)((__attribute__((address_space(3))) char*)shm+LDS_BIAS);
  lds_f* const knl=blp+SEQ+64;
  { int z_=0; asm volatile("":"+v"(z_)); const float cref=cum[q0+z_]; const int n4=(q0+QB)>>2;
    for(int i=tid;i<n4;i+=NW*64){ f32x4v v=*reinterpret_cast<const f32x4v*>(cum+4*i); v=cref-v; *(lds_f4*)(blp+4*i)=v; }
    if(tid<NT) knl[tid]=__builtin_sqrtf(__uint_as_float(kn[2*tid])+__uint_as_float(kn[2*tid+1])); }
  bf16x8 qr[4];
  #pragma unroll
  for(int d0=0;d0<4;++d0)qr[d0]=*reinterpret_cast<const bf16x8*>(&Qw[(long)r32*DM+d0*16+hi*8]);
  { float qs=0.f;
    #pragma unroll
    for(int d0=0;d0<4;++d0)
      #pragma unroll
      for(int j=0;j<8;++j){ const float v=__uint_as_float(((unsigned)(unsigned short)qr[d0][j])<<16); qs+=v*v; }
    { auto rr=__builtin_amdgcn_permlane32_swap(__float_as_uint(qs),__float_as_uint(qs),false,false); qs=__uint_as_float(rr[0])+__uint_as_float(rr[1]); }
    #pragma unroll
    for(int o_=1;o_<32;o_<<=1) qs=__builtin_fmaxf(qs,__shfl_xor(qs,o_));
    if(lane==0) knl[128+wid]=qs; }
  asm volatile("s_waitcnt vmcnt(0) lgkmcnt(0)\n\ts_barrier":::"memory");
  int t_start;
  { float q2=knl[128];
    #pragma unroll
    for(int w_=1;w_<NW;++w_) q2=__builtin_fmaxf(q2,knl[128+w_]);
    const float qm=1.03f*__builtin_sqrtf(q2);
    const float ksel=__builtin_fmaxf(__builtin_fmaxf(knl[NT-4],knl[NT-3]),__builtin_fmaxf(knl[NT-2],knl[NT-1]));
    const int t0_=lane,t1_=lane+64;
    const bool ok0=(t0_<NT-4)&&(blp[64*t0_+63]+qm*(knl[t0_]+ksel)<=-152.f);
    const bool ok1=(t1_<NT-4)&&(blp[64*t1_+63]+qm*(knl[t1_]+ksel)<=-152.f);
    const unsigned long long m0=~__ballot(ok0),m1=~__ballot(ok1);
    const int f0=m0?__builtin_ctzll(m0):64,f1=m1?__builtin_ctzll(m1):64;
    t_start=(f0<64)?f0:64+f1; t_start=(t_start>NT-4)?NT-4:t_start; t_start&=~1; t_start=__builtin_amdgcn_readfirstlane(t_start); }
  NT-=t_start;
  const bf16*Kh=K+(rowbase+(long)t_start*KVBLK)*DM+h*D,*Vh=V+(rowbase+(long)t_start*KVBLK)*DM+h*D;
  const bf16*ksrc=Kh+(long)lane*DM+wid*8;
  const bf16*vsrc=Vh+(long)(16*(wid&3)+(lane>>2))*DM+(wid>>2)*32+(lane&3)*8;
  const unsigned kdst=lds0+LDS_K+wid*1024, vdst=lds0+LDS_V+wid*1024;
  #define DMA_K(t,slot) glds16(ksrc+(long)(t)*KVBLK*DM,(unsigned)__builtin_amdgcn_readfirstlane(kdst+(slot)))
  #define DMA_V(t,slot) glds16(vsrc+(long)(t)*KVBLK*DM,(unsigned)__builtin_amdgcn_readfirstlane(vdst+(slot)))
  const int vb0=(int)(lds0+LDS_V)+((lane>>4)&1)*32+(lane&3)*8+(4*hi+((lane&15)>>2))*64;
  const char*Kbase=shm+LDS_K; bf16x8 kf[8];
  const lds_cptr shm3=(lds_cptr)shm; const lds_cptr kp0=shm3+LDS_K+hi*1024+r32*16; const lds_cptr vp0=shm3+LDS_V+((lane>>4)&1)*32+(lane&3)*8+(4*hi+((lane&15)>>2))*64;
  const lds_f* const bq0=blp+4*hi+t_start*KVBLK;
  DMA_K(0,0);DMA_V(0,0);DMA_K(1,SLOTB);
  float mhat=blp[q0+wid*QBLK+r32],l_reg=0.f;f32x16 o[2];o[0]=f32x16{};o[1]=f32x16{};
  const int qrel=wid*QBLK+r32;
  #define CMASK(P0,P1,t) do{int jb_=(t)-(NT-4); if(jb_>=0)cmask(P0,P1,jb_,qrel,hi);}while(0)
  bool resc=false;
  #define BINIT(P0,P1,t) do{ const lds_f* b_=bq0+(t)*KVBLK; _Pragma("unroll") for(int i_=0;i_<4;++i_){ const f32x4v x0_=*(const lds_f4*)(b_+8*i_), x1_=*(const lds_f4*)(b_+32+8*i_); \
      _Pragma("unroll") for(int k_=0;k_<4;++k_){ P0[4*i_+k_]=x0_[k_]-mhat; P1[4*i_+k_]=x1_[k_]-mhat; } } }while(0)
  #define START(P0,P1) do{ const float rm=rowmax(P0,P1); resc=false; \
    { const float dl=__builtin_fmaxf(rm,0.f); mhat=fadd_s(mhat,dl); \
      _Pragma("unroll") for(int r=0;r<16;++r){P0[r]=fsub_s(P0[r],dl);P1[r]=fsub_s(P1[r],dl);} \
      } \
    _Pragma("unroll") for(int r=0;r<16;++r)P0[r]=__builtin_amdgcn_exp2f(P0[r]); }while(0)
  #define RESC() do{ if(resc){ asm volatile("s_waitcnt lgkmcnt(0)":::"memory"); \
      _Pragma("unroll") for(int d_=0;d_<2;++d_) _Pragma("unroll") for(int r=0;r<16;++r)o[d_][r]*=wsf[crow(r,hi)]; } }while(0)
  f32x16 pA0,pA1,pB0,pB1;
  int sl_prev=0,sl_cur=0,sl_next=SLOTB;
  #define ROT() do{sl_prev=sl_cur;sl_cur=sl_next;sl_next=(sl_next==(NSLOT-1)*SLOTB)?0:sl_next+SLOTB;}while(0)
  DMA_K(2,2*SLOTB);
  WAIT_BAR(3);
  BINIT(pA0,pA1,0);
  qkt(pA0,pA1,Kbase,qr,r32,hi);asm volatile("s_nop 15\n\ts_nop 7":"+v"(pA0),"+v"(pA1));CMASK(pA0,pA1,0);
  START(pA0,pA1);
  _Pragma("unroll") for(int r=0;r<16;++r)pA1[r]=__builtin_amdgcn_exp2f(pA1[r]);
  BINIT(pB0,pB1,1);
  WAIT_BAR(0);
  DMA_K(3,0);DMA_V(1,SLOTB);
  ROT();
  kload8(kf,kp0+sl_cur);
  WAIT_BAR(2);
  s16x4 vlo[8],vhi[8]; u32x4 pw0,pw1,pw2,pw3;
  #define PKW(P,B) cvtpk_s(P[B],P[B+1])
  #define PAF(k) __builtin_bit_cast(bf16x8,pw##k)
  #define VFR(i) (bf16x8){vlo[i][0],vlo[i][1],vlo[i][2],vlo[i][3],vhi[i][0],vhi[i][1],vhi[i][2],vhi[i][3]}
  #define PIN(x) asm volatile("":"+v"(x))
  #define MX3(a,b,c) __builtin_fmaxf(__builtin_fmaxf((a),(b)),(c))
  #define GAPA(MF,A0,A1,A2,A3,W0,W1,PW) do{ MF; sacc+=A0; sacc+=A1; sacc+=A2; sacc+=A3; PIN(sacc); W0; W1; PIN(PW); SBAR(); }while(0)
  #define EX(v) __builtin_amdgcn_exp2f(v)
  #define GAPB(MF,X,B,XTRA) do{ MF; X[B]=EX(X[B]); X[B+1]=EX(X[B+1]); X[B+2]=EX(X[B+2]); X[B+3]=EX(X[B+3]); PIN(X); XTRA; SBAR(); }while(0)
  #define BLD(dst,off) dst=*(const lds_f4*)(bqn_+(off))
  #define BSB(P,i,src) do{ P[4*(i)]=src[0]-mhat; P[4*(i)+1]=src[1]-mhat; P[4*(i)+2]=src[2]-mhat; P[4*(i)+3]=src[3]-mhat; PIN(P); }while(0)
  #define VRD(i) do{ vlo[i]=vtr(vp_+(((i)>>2)*4096+((i)&3)*1024)); vhi[i]=vtr(vp_+(((i)>>2)*4096+((i)&3)*1024+512)); }while(0)
  #define KRD(G,j) do{ if(G){ kload2(kf,kp0+sl_next,j); SBAR(); } }while(0)
  #define STEP(C0,C1,P0,P1,t,GK,GV,GL) do{ SBAR(); \
    const lds_cptr vp_=vp0+sl_prev; const lds_f* const bqn_=bq0+((t)+1)*KVBLK; f32x4v bta_,btb_; \
    VRD(0); SBAR(); float sacc=(P0[0]+P0[1]); \
    GAPA(C0=__builtin_amdgcn_mfma_f32_32x32x16_bf16(kf[0],qr[0],C0,0,0,0), P0[2],P0[3],P0[4],P0[5],     pw0[0]=PKW(P0,0), pw0[1]=PKW(P0,2), pw0); \
    VRD(4); SBAR(); GAPA(C1=__builtin_amdgcn_mfma_f32_32x32x16_bf16(kf[1],qr[0],C1,0,0,0), P0[6],P0[7],P0[8],P0[9],     pw0[2]=PKW(P0,4), pw0[3]=PKW(P0,6), pw0); \
    VRD(1); SBAR(); GAPA(C0=__builtin_amdgcn_mfma_f32_32x32x16_bf16(kf[2],qr[1],C0,0,0,0),   P0[10],P0[11],P0[12],P0[13], pw1[0]=PKW(P0,8), pw1[1]=PKW(P0,10), pw1); \
    VRD(5); SBAR(); GAPA(C1=__builtin_amdgcn_mfma_f32_32x32x16_bf16(kf[3],qr[1],C1,0,0,0),   P0[14],P0[15],P1[0],P1[1],   pw1[2]=PKW(P0,12),pw1[3]=PKW(P0,14), pw1); \
    VRD(2); SBAR(); GAPA(C0=__builtin_amdgcn_mfma_f32_32x32x16_bf16(kf[4],qr[2],C0,0,0,0),   P1[2],P1[3],P1[4],P1[5],     pw2[0]=PKW(P1,0), pw2[1]=PKW(P1,2), pw2); \
    VRD(6); SBAR(); GAPA(C1=__builtin_amdgcn_mfma_f32_32x32x16_bf16(kf[5],qr[2],C1,0,0,0),   P1[6],P1[7],P1[8],P1[9],     pw2[2]=PKW(P1,4), pw2[3]=PKW(P1,6), pw2); \
    VRD(3); SBAR(); GAPA(C0=__builtin_amdgcn_mfma_f32_32x32x16_bf16(kf[6],qr[3],C0,0,0,0),   P1[10],P1[11],P1[12],P1[13], pw3[0]=PKW(P1,8), pw3[1]=PKW(P1,10), pw3); \
    VRD(7); SBAR(); GAPA(C1=__builtin_amdgcn_mfma_f32_32x32x16_bf16(kf[7],qr[3],C1,0,0,0),   P1[14],P1[15],0.f,0.f,       pw3[2]=PKW(P1,12),pw3[3]=PKW(P1,14), pw3); \
    l_reg+=sacc; \
    if(GK){DMA_K((t)+3,sl_cur);} if(GV){DMA_V((t)+1,sl_next);} \
    CMASK(C0,C1,t); \
    { float a=MX3(C0[0],C0[1],C1[0]),b=MX3(C0[2],C0[3],C1[1]); a=MX3(a,C1[2],C1[3]); \
      _Pragma("unroll") for(int r=4;r<16;r+=4){a=MX3(a,C0[r],C0[r+1]);b=MX3(b,C0[r+2],C0[r+3]);a=MX3(a,C1[r],C1[r+1]);b=MX3(b,C1[r+2],C1[r+3]);} \
      float rm=__builtin_fmaxf(a,b); { auto rr=__builtin_amdgcn_permlane32_swap(__float_as_uint(rm),__float_as_uint(rm),false,false); rm=__builtin_fmaxf(__uint_as_float(rr[0]),__uint_as_float(rr[1])); } \
      resc=false; \
      if(__builtin_expect(__any(rm>(float)THRL),0)){ const float dl=__builtin_fmaxf(rm,0.f); mhat+=dl; \
        _Pragma("unroll") for(int r=0;r<16;++r){C0[r]-=dl;C1[r]-=dl;} \
        const float f=__builtin_amdgcn_exp2f(-dl); l_reg*=f; if(hi==0)wsf[r32]=f; resc=true; } } \
    SBAR(); \
    GAPB(o[0]=__builtin_amdgcn_mfma_f32_32x32x16_bf16(PAF(0),VFR(0),o[0],0,0,0), C0,0, BLD(bta_,0)); \
    GAPB(o[1]=__builtin_amdgcn_mfma_f32_32x32x16_bf16(PAF(0),VFR(4),o[1],0,0,0), C0,4, BLD(btb_,8);BSB(P0,0,bta_)); \
    KRD(GL,0); GAPB(o[0]=__builtin_amdgcn_mfma_f32_32x32x16_bf16(PAF(1),VFR(1),o[0],0,0,0), C0,8, BLD(bta_,16);BSB(P0,1,btb_)); \
    KRD(GL,1); GAPB(o[1]=__builtin_amdgcn_mfma_f32_32x32x16_bf16(PAF(1),VFR(5),o[1],0,0,0), C0,12, BLD(btb_,24);BSB(P0,2,bta_)); \
    KRD(GL,2); GAPB(o[0]=__builtin_amdgcn_mfma_f32_32x32x16_bf16(PAF(2),VFR(2),o[0],0,0,0), C1,0, BLD(bta_,32);BSB(P0,3,btb_)); \
    KRD(GL,3); GAPB(o[1]=__builtin_amdgcn_mfma_f32_32x32x16_bf16(PAF(2),VFR(6),o[1],0,0,0), C1,4, BLD(btb_,40);BSB(P1,0,bta_)); \
    GAPB(o[0]=__builtin_amdgcn_mfma_f32_32x32x16_bf16(PAF(3),VFR(3),o[0],0,0,0), C1,8, BLD(bta_,48);BSB(P1,1,btb_)); \
    GAPB(o[1]=__builtin_amdgcn_mfma_f32_32x32x16_bf16(PAF(3),VFR(7),o[1],0,0,0), C1,12, BLD(btb_,56);BSB(P1,2,bta_)); \
    BSB(P1,3,btb_); \
    }while(0)
  int t=1;
  #undef CMASK
  #define CMASK(P0,P1,t) do{}while(0)
  for(;t+5<NT;t+=2){
    STEP(pB0,pB1,pA0,pA1,t,true,true,true);     WAIT_BAR(2); RESC(); ROT();
    STEP(pA0,pA1,pB0,pB1,t+1,true,true,true);   WAIT_BAR(2); RESC(); ROT();
  }
  #undef CMASK
  #define CMASK(P0,P1,t) do{int jb_=(t)-(NT-4); if(jb_>=0)cmask(P0,P1,jb_,qrel,hi);}while(0)
  #define ENDW(tt) do{ if((tt)+3<NT){WAIT_BAR(2);} else if((tt)+2<NT){WAIT_BAR(1);} else {WAIT_BAR(0);} }while(0)
  for(;t+1<NT;t+=2){
    STEP(pB0,pB1,pA0,pA1,t,(t+3<NT),(t+1<NT),(t+1<NT));       ENDW(t);   RESC(); ROT();
    STEP(pA0,pA1,pB0,pB1,t+1,(t+4<NT),(t+2<NT),(t+2<NT));     ENDW(t+1); RESC(); ROT();
  }
  STEP(pB0,pB1,pA0,pA1,NT-1,false,false,false); RESC();
  { float sacc=pB0[0]+pB0[1]; _Pragma("unroll") for(int r=2;r<16;++r)sacc+=pB0[r]; _Pragma("unroll") for(int r=0;r<16;++r)sacc+=pB1[r]; l_reg+=sacc;
    pw0=(u32x4){PKW(pB0,0),PKW(pB0,2),PKW(pB0,4),PKW(pB0,6)};pw1=(u32x4){PKW(pB0,8),PKW(pB0,10),PKW(pB0,12),PKW(pB0,14)};pw2=(u32x4){PKW(pB1,0),PKW(pB1,2),PKW(pB1,4),PKW(pB1,6)};pw3=(u32x4){PKW(pB1,8),PKW(pB1,10),PKW(pB1,12),PKW(pB1,14)};
    SBAR(); pv(o,vb0+sl_cur,PAF(0),PAF(1),PAF(2),PAF(3)); }
  #undef PKW
  #undef PAF
  #undef VFR
  #undef PIN
  #undef MX3
  #undef GAPA
  #undef GAPB
  #undef BLD
  #undef BSB
  #undef BINIT
  #undef EX
  #undef VRD
  #undef KRD
  #undef STEP
  #undef ENDW
  {auto rr=__builtin_amdgcn_permlane32_swap(__float_as_uint(l_reg),__float_as_uint(l_reg),false,false);l_reg=__uint_as_float(rr[0])+__uint_as_float(rr[1]);}
  if(hi==0)wsf[32+r32]=l_reg;asm volatile("s_waitcnt lgkmcnt(0)":::"memory");
  float rli[16];
  #pragma unroll
  for(int r=0;r<16;++r)rli[r]=__builtin_amdgcn_rcpf(wsf[32+crow(r,hi)]);
  bf16*Ow=O+(rowbase+q0+wid*QBLK)*DM+h*D;
  { bf16*stg=(bf16*)(shm+LDS_OST)+wid*2048;
    #pragma unroll
    for(int r=0;r<16;++r){const int orow=crow(r,hi);
      #pragma unroll
      for(int d0=0;d0<2;++d0)stg[orow*64+d0*32+r32]=__float2bfloat16(o[d0][r]*rli[r]);}
    asm volatile("s_waitcnt lgkmcnt(0)":::"memory");
    const int ch=lane&7; const bf16*Gw=Gp+(rowbase+q0+wid*QBLK)*DM+h*D;
    const f32x4v ga=*reinterpret_cast<const f32x4v*>(ggrp+h*D+ch*8),gb=*reinterpret_cast<const f32x4v*>(ggrp+h*D+ch*8+4);
    const float gg[8]={ga[0],ga[1],ga[2],ga[3],gb[0],gb[1],gb[2],gb[3]};
    #pragma unroll
    for(int i=0;i<4;++i){const int row=i*8+(lane>>3); const u32x4 v=*(const u32x4*)(stg+row*64+ch*8); const u32x4 gv=*reinterpret_cast<const u32x4*>(Gw+(long)row*DM+ch*8);
      float s=0.f; u32x4 y;
      #pragma unroll
      for(int k=0;k<4;++k){ const float a0=__uint_as_float(v[k]<<16),a1=__uint_as_float(v[k]&0xffff0000u),g0=__uint_as_float(gv[k]<<16),g1=__uint_as_float(gv[k]&0xffff0000u);
        s+=a0*a0+a1*a1; y[k]=cvtpk_s(a0*gg[2*k]*silu2(g0),a1*gg[2*k+1]*silu2(g1)); }
      s+=__shfl_xor(s,1); s+=__shfl_xor(s,2); s+=__shfl_xor(s,4);
      if(ch==0)ssq[(rowbase+q0+wid*QBLK+row)*16+h]=s;
      ATTN_STORE16(Ow+(long)row*DM+ch*8,y);} }
  asm volatile("s_waitcnt lgkmcnt(0)\n\ts_barrier":::"memory");
  #undef DMA_K
  #undef DMA_V
  #undef CMASK
  #undef START
  #undef RESC
  #undef ROT
}
constexpr int ATTN_LDS_BYTES=LDS_BYTES;
constexpr float SB_EXIT=150.f;
__device__ __forceinline__ void sb_unit(int b,int h,int qb,const bf16*Q,const bf16*__restrict__ K,const bf16*__restrict__ VT,bf16*O,const bf16*__restrict__ Gp,const float*__restrict__ ggrp,float*__restrict__ ssq){
  int tid_o=threadIdx.x; asm volatile("":"+v"(tid_o)); const int tid=tid_o,lane=tid&63,r32=lane&31,hi=lane>>5; const int wid=__builtin_amdgcn_readfirstlane(tid>>6);
  const long rowbase=(long)b*SEQ; const int q0=qb*QB+wid*QBLK;
  const bf16*Qw=Q+(rowbase+q0)*DM+h*D;
  const int pi=16*((r32>>2)&1)+(r32&3)+4*(r32>>3);
  const bf16*Kl=K+(rowbase+pi)*DM+h*D+hi*8;
  const bf16*Vl=VT+((long)((b*8+h)*64+r32))*SEQ+16*hi;
  bf16x8 qr[4];
  #pragma unroll
  for(int d0=0;d0<4;++d0)qr[d0]=*reinterpret_cast<const bf16x8*>(&Qw[(long)r32*DM+d0*16+hi*8]);
  f32x16 o0=f32x16{},o1=f32x16{};
  float carry=0.f; const int qabs=q0+r32; const int ktd=q0>>5;
  bf16x8 kc[4],vc[4],kx[4],vx[4];
  #define SB_LOAD(KF,VF,kt_) do{ const bf16*kp_=Kl+(long)(kt_)*32*DM; const bf16*vp_=Vl+(kt_)*32; \
    _Pragma("unroll") for(int d0=0;d0<4;++d0)KF[d0]=*reinterpret_cast<const bf16x8*>(kp_+16*d0); \
    VF[0]=*reinterpret_cast<const bf16x8*>(vp_); VF[1]=*reinterpret_cast<const bf16x8*>(vp_+8); VF[2]=*reinterpret_cast<const bf16x8*>(vp_+32*SEQ); VF[3]=*reinterpret_cast<const bf16x8*>(vp_+32*SEQ+8); }while(0)
  SB_LOAD(kc,vc,ktd);
  for(int kt=ktd;kt>=0;--kt){
    const int kbase=kt*32;
    { const int ktn=kt>0?kt-1:0; SB_LOAD(kx,vx,ktn); }
    f32x16 p=f32x16{};
    p=__builtin_amdgcn_mfma_f32_32x32x16_bf16(kc[0],qr[0],p,0,0,0);p=__builtin_amdgcn_mfma_f32_32x32x16_bf16(kc[1],qr[1],p,0,0,0);
    p=__builtin_amdgcn_mfma_f32_32x32x16_bf16(kc[2],qr[2],p,0,0,0);p=__builtin_amdgcn_mfma_f32_32x32x16_bf16(kc[3],qr[3],p,0,0,0);
    const bool diag=(kt==ktd); const int key0=kbase+16*hi;
    float l2[16];
    #pragma unroll
    for(int r=0;r<16;++r){ const float t=p[r]; float l=__builtin_amdgcn_logf(1.0f+__builtin_amdgcn_exp2f(t)); l=(t>30.f)?t:l;
      if(diag){ if(key0+r>=qabs)l=0.f; } l2[r]=l; }
    float g[4];
    #pragma unroll
    for(int i=0;i<4;++i)g[i]=(l2[4*i]+l2[4*i+1])+(l2[4*i+2]+l2[4*i+3]);
    const float tot=(g[0]+g[1])+(g[2]+g[3]);
    float pt; { auto rr=__builtin_amdgcn_permlane32_swap(__float_as_uint(tot),__float_as_uint(tot),false,false); const unsigned tu=__float_as_uint(tot); pt=__uint_as_float(rr[0]==tu?rr[1]:rr[0]); }
    float suf[4]; suf[3]=carry+(hi?0.f:pt); suf[2]=suf[3]+g[3]; suf[1]=suf[2]+g[2]; suf[0]=suf[1]+g[1];
    carry+=tot+pt;
    float a[16];
    #pragma unroll
    for(int i=0;i<4;++i){ float c=suf[i];
      #pragma unroll
      for(int k=3;k>=0;--k){ const int r=4*i+k; c+=l2[r]; float av=__builtin_amdgcn_exp2f(p[r]-c); if(diag){ if(key0+r>=qabs)av=0.f; } a[r]=av; } }
    u32x4 w0,w1; w0[0]=cvtpk_s(a[0],a[1]);w0[1]=cvtpk_s(a[2],a[3]);w0[2]=cvtpk_s(a[4],a[5]);w0[3]=cvtpk_s(a[6],a[7]);
    w1[0]=cvtpk_s(a[8],a[9]);w1[1]=cvtpk_s(a[10],a[11]);w1[2]=cvtpk_s(a[12],a[13]);w1[3]=cvtpk_s(a[14],a[15]);
    const bf16x8 pa0=__builtin_bit_cast(bf16x8,w0),pa1=__builtin_bit_cast(bf16x8,w1);
    o0=__builtin_amdgcn_mfma_f32_32x32x16_bf16(pa0,vc[0],o0,0,0,0);o1=__builtin_amdgcn_mfma_f32_32x32x16_bf16(pa0,vc[2],o1,0,0,0);
    o0=__builtin_amdgcn_mfma_f32_32x32x16_bf16(pa1,vc[1],o0,0,0,0);o1=__builtin_amdgcn_mfma_f32_32x32x16_bf16(pa1,vc[3],o1,0,0,0);
    if(__all(carry>=SB_EXIT))break;
    #pragma unroll
    for(int d0=0;d0<4;++d0){kc[d0]=kx[d0];vc[d0]=vx[d0];}
  }
  #undef SB_LOAD
  unsigned short*Ow=(unsigned short*)(O+(rowbase+q0)*DM+h*D);
  const unsigned short*Gw=(const unsigned short*)(Gp+(rowbase+q0)*DM+h*D); const float gg0=ggrp[h*D+r32],gg1=ggrp[h*D+32+r32];
  #pragma unroll
  for(int r=0;r<16;++r){ const long ro=(long)crow(r,hi)*DM; const float a0=o0[r],a1=o1[r];
    float s=a0*a0+a1*a1;
    #pragma unroll
    for(int o_=1;o_<32;o_<<=1)s+=__shfl_xor(s,o_);
    if(r32==0)ssq[(rowbase+q0+crow(r,hi))*16+h]=s;
    const float g0=__uint_as_float(((unsigned)Gw[ro+r32])<<16),g1=__uint_as_float(((unsigned)Gw[ro+32+r32])<<16);
    const unsigned w=cvtpk_s(a0*gg0*silu2(g0),a1*gg1*silu2(g1));
    Ow[ro+r32]=(unsigned short)(w&0xffffu); Ow[ro+32+r32]=(unsigned short)(w>>16); }
}
struct AttnTensors { const bf16* Q; const bf16* K; const bf16* V; bf16* O; const float* cum; };

#undef SBAR
#undef WAIT_BAR
}
constexpr int NWAVES = 8;
#ifndef PROBE_DUP
#define PROBE_DUP 0
#endif
#ifndef MK_PER_PHASE
#define MK_PER_PHASE 0
#endif
constexpr int BATCH = 2, T = 8192, D = 1024, DEPTH = 4, NHEADS = 16, HD = 64;
constexpr int M = BATCH * T;
constexpr int D_IN = 4104, NPROJ = 4096;
constexpr float EPS = 1e-6f, LOG2E = 1.4426950408889634f;
constexpr size_t MiB = 1u << 20;
constexpr size_t WS_CTL = 0, CTL_ZERO_BYTES = 256 * 1024;
constexpr size_t WS_BAR = 16 * 1024, WS_QCTR = 32 * 1024, WS_KN = 64 * 1024;
constexpr size_t WS_BAR_UNUSED_ = 0;
constexpr size_t WS_ADA = 512 * 1024;
constexpr size_t WS_WFP = 768 * 1024;
constexpr size_t WS_LOGF = 1 * MiB;
constexpr size_t WS_CUM = WS_LOGF + 512 * 1024;
constexpr size_t WS_WIN = 2 * MiB;
constexpr size_t WS_WOUT = WS_WIN + (size_t)DEPTH * NPROJ * D * 2;
constexpr size_t WS_XN = 42 * MiB;
constexpr size_t WS_QO = 74 * MiB, WS_K = 106 * MiB, WS_V = 138 * MiB, WS_G = 170 * MiB, WS_O = 202 * MiB, WS_SSQ = 234 * MiB, WS_VT = 235 * MiB, WS_END = 251 * MiB;
static_assert(WS_WOUT + (size_t)DEPTH * D * D * 2 <= WS_XN && WS_XN + (size_t)M * D * 2 <= WS_QO, "d_ws map");
constexpr int RING_BYTES = 131072, LDS_BYTES = 147456, MISC_OFF = RING_BYTES + 320, BARST_OFF = MISC_OFF + 64;
static_assert(attn_body::ATTN_LDS_BYTES <= RING_BYTES, "attention LDS");

#define GAS __attribute__((address_space(1)))
#define LAS __attribute__((address_space(3)))
typedef unsigned short bf16;
typedef unsigned v4u __attribute__((ext_vector_type(4)));
typedef float f32x4 __attribute__((ext_vector_type(4)));
#define LDS_WAIT() asm volatile("s_waitcnt lgkmcnt(0)" ::: "memory")
__device__ __forceinline__ unsigned f2bf(float f) { unsigned u = __builtin_bit_cast(unsigned, f); return (u + 0x7fffu + ((u >> 16) & 1u)) >> 16; }
__device__ __forceinline__ unsigned pk2(float lo, float hi) { return f2bf(lo) | (f2bf(hi) << 16); }
__device__ __forceinline__ float bf_lo(unsigned w) { return __uint_as_float(w << 16); }
__device__ __forceinline__ float bf_hi(unsigned w) { return __uint_as_float(w & 0xffff0000u); }
__device__ __forceinline__ float wave_sum(float v) {
#pragma unroll
    for (int o = 1; o < 64; o <<= 1) v += __shfl_xor(v, o);
    return v;
}
__device__ __forceinline__ void transpose_item(const float* W, int ldw, int k0, int n0, bf16* WT, int ldt, int drow0, LAS float* scr, int lane) {
#pragma unroll 8
    for (int i = 0; i < 32; ++i) { const int kk = 2 * i + (lane >> 5); scr[kk * 33 + (lane & 31)] = W[(size_t)(k0 + kk) * ldw + n0 + (lane & 31)]; }
    LDS_WAIT(); asm volatile("" ::: "memory");
    const int c = lane & 7;
#pragma unroll
    for (int j = 0; j < 4; ++j) { const int n = (lane >> 3) + 8 * j; const LAS float* s = scr + (8 * c) * 33 + n;
        v4u o; o.x = pk2(s[0 * 33], s[1 * 33]); o.y = pk2(s[2 * 33], s[3 * 33]); o.z = pk2(s[4 * 33], s[5 * 33]); o.w = pk2(s[6 * 33], s[7 * 33]);
        *(v4u*)(WT + (size_t)(drow0 + n) * ldt + k0 + 8 * c) = o; }
    LDS_WAIT(); asm volatile("" ::: "memory");
}
__device__ __forceinline__ float silu_f(float x) { return x * __builtin_amdgcn_rcpf(1.0f + __builtin_amdgcn_exp2f(-x * LOG2E)); }

#define XB_TMO      128
#define XB_XCNT(j)  (256  + 64 * (j))
#define XB_XSUB(j)  (1280 + 64 * (j))
#define XB_XGEN(j)  (2304 + 64 * (j))
#define XB_TOP      3328
#define XB_TOPGEN   3392
#define XCD_BAR_WORDS 3456
#define XB_SPIN_CAP (1u << 18)

__device__ __forceinline__ unsigned xb_ld(unsigned* p)              { return __hip_atomic_load(p, __ATOMIC_RELAXED, __HIP_MEMORY_SCOPE_AGENT); }
__device__ __forceinline__ unsigned xb_add(unsigned* p, unsigned v) { return __hip_atomic_fetch_add(p, v, __ATOMIC_RELAXED, __HIP_MEMORY_SCOPE_AGENT); }
__device__ __forceinline__ unsigned xb_xcc_id() { return (unsigned)__builtin_amdgcn_s_getreg((3 << 11) | 20) & 0xFu; }
#define XB_SPIN(cond, bar) do { unsigned _sp = 0; while (cond) { __builtin_amdgcn_s_sleep(1); \
    if ((++_sp & 255u) == 0u) { if (xb_ld(&(bar)[XB_TMO])) break; if (_sp > XB_SPIN_CAP) { atomicAdd(&(bar)[XB_TMO], 1u); break; } } } } while (0)

struct XcdBarrier {
    unsigned* bar; unsigned x;
    volatile LAS unsigned* st;
};

__device__ __forceinline__ XcdBarrier xcd_barrier_post(unsigned* bar, volatile LAS unsigned* st) {
    XcdBarrier b; b.bar = bar; b.x = xb_xcc_id(); b.st = st;
    if (threadIdx.x == 0) (void)xb_add(&bar[XB_XCNT(b.x)], 1u);
    return b;
}
__device__ __forceinline__ void xcd_barrier_complete(unsigned* bar, unsigned x, unsigned& nloc, unsigned& nx) {
    const unsigned G = gridDim.x * gridDim.y * gridDim.z;
    unsigned sum, cnt, mine, sp = 0u;
    for (;;) {
        sum = 0u; cnt = 0u; mine = 0u;
#pragma unroll
        for (unsigned j = 0; j < 16; ++j) { const unsigned c = xb_ld(&bar[XB_XCNT(j)]); sum += c; cnt += (c > 0u) ? 1u : 0u; mine = (j == x) ? c : mine; }
        if (sum == G) break;
        __builtin_amdgcn_s_sleep(1);
        if ((++sp & 255u) == 0u) { if (xb_ld(&bar[XB_TMO])) break; if (sp > XB_SPIN_CAP) { atomicAdd(&bar[XB_TMO], 1u); break; } }
    }
    nloc = mine > 0u ? mine : 1u; nx = cnt > 0u ? cnt : 1u;
}

__device__ __forceinline__ void xcd_barrier(const XcdBarrier& b) {
    asm volatile("s_waitcnt vmcnt(0)" ::: "memory");
    __syncthreads();
    if (threadIdx.x == 0) {
        unsigned* bar = b.bar;
        __builtin_amdgcn_s_waitcnt(0);
        unsigned nloc = b.st[0], nx = b.st[1];
        if (nloc == 0u) { xcd_barrier_complete(bar, b.x, nloc, nx); b.st[0] = nloc; b.st[1] = nx; }
        const unsigned old = xb_add(&bar[XB_XSUB(b.x)], 1u);
        const unsigned gen = old / nloc;
        if (old + 1u == (gen + 1u) * nloc) {
            __builtin_amdgcn_fence(__ATOMIC_RELEASE, "agent");
            asm volatile("s_waitcnt vmcnt(0)" ::: "memory");
            const unsigned og = xb_add(&bar[XB_TOP], 1u);
            const unsigned tg = og / nx;
            if (og + 1u == (tg + 1u) * nx) xb_add(&bar[XB_TOPGEN], 1u);
            else XB_SPIN(xb_ld(&bar[XB_TOPGEN]) == tg, bar);
            __builtin_amdgcn_fence(__ATOMIC_ACQUIRE, "agent");
            xb_add(&bar[XB_XGEN(b.x)], 1u);
            asm volatile("s_waitcnt vmcnt(0)" ::: "memory");
        } else {
            XB_SPIN(xb_ld(&bar[XB_XGEN(b.x)]) == gen, bar);
            __builtin_amdgcn_fence(__ATOMIC_ACQUIRE, "agent");
            asm volatile("s_waitcnt vmcnt(0)" ::: "memory");
        }
    }
    __syncthreads();
}

struct Args { const float* in[10]; float* out; unsigned char* ws; int ph_lo, ph_hi; };
constexpr int N_PHASES = 2 + 4 * DEPTH;

__global__ void __launch_bounds__(NWAVES * 64, 2) hyb_fwd(Args args) {
    extern __shared__ __attribute__((aligned(16))) unsigned char lds[];
    LAS unsigned char* const L = (LAS unsigned char*)lds;
#define PHASE_IDS() int tid_o = threadIdx.x; asm volatile("" : "+v"(tid_o)); const int tid = tid_o, lane = tid & 63, wave = __builtin_amdgcn_readfirstlane(tid >> 6); const int gw = vcu * NWAVES + wave; (void)tid; (void)lane; (void)gw
    const int G = gridDim.x; const int bx = blockIdx.x; const int vcu = (G % 8 == 0) ? (bx % 8) * (G / 8) + bx / 8 : bx;
    const int NGW = G * NWAVES;
    unsigned char* const ws = args.ws;
    const float* x_in = args.in[0]; const float* c_in = args.in[1]; const float* w_ada = args.in[2]; const float* b_ada = args.in[3]; const float* g_norm = args.in[4];
    const float* w_in = args.in[5]; const float* b_f = args.in[6]; const float* g_grp = args.in[7]; const float* w_out = args.in[8]; const float* g_final = args.in[9];
    float* const out = args.out;
    float* const ADA = (float*)(ws + WS_ADA); float* const LOGF = (float*)(ws + WS_LOGF); float* const CUM = (float*)(ws + WS_CUM);
    bf16* const WIN = (bf16*)(ws + WS_WIN); bf16* const WOUT = (bf16*)(ws + WS_WOUT); bf16* const XN = (bf16*)(ws + WS_XN);
    bf16* const QO = (bf16*)(ws + WS_QO); bf16* const KB = (bf16*)(ws + WS_K); bf16* const VB = (bf16*)(ws + WS_V); bf16* const GB = (bf16*)(ws + WS_G); bf16* const OB = (bf16*)(ws + WS_O); unsigned* const KN = (unsigned*)(ws + WS_KN); unsigned* const QCTR = (unsigned*)(ws + WS_QCTR); float* const SSQ = (float*)(ws + WS_SSQ); float* const WFP = (float*)(ws + WS_WFP); bf16* const VT = (bf16*)(ws + WS_VT);
    const int lo = args.ph_lo, hi_ph = args.ph_hi;
    cg::grid_group grid = cg::this_grid();
    for (int u = threadIdx.x; u < (LDS_BYTES - RING_BYTES) / 4; u += NWAVES * 64) ((LAS unsigned*)(L + RING_BYTES))[u] = 0u;
    __syncthreads();
    XcdBarrier bar = xcd_barrier_post((unsigned*)(ws + WS_BAR), (volatile LAS unsigned*)(L + BARST_OFF));
    if (lo < 0) grid.sync();
#define IN(k) (lo <= (k) && (k) < hi_ph)
#define SEAM(k) do { if (IN(k) && IN((k) + 1)) xcd_barrier(bar); } while (0)

    if (IN(0)) { PHASE_IDS();
        LAS float* scr = (LAS float*)(L + wave * 16384);
        constexpr int I_IN = (D / 64) * (NPROJ / 32), I_OUT = (D / 64) * (D / 32), I_L = I_IN + I_OUT;
        for (int it = gw; it < DEPTH * I_L; it += NGW) {
            const int l = it / I_L; int r = it % I_L;
            if (r < I_IN) { const int kb = r / (NPROJ / 32), db = r % (NPROJ / 32), seg = db >> 4;
                const int sseg = seg == 1 ? 3 : seg == 2 ? 1 : seg == 3 ? 4 : seg == 4 ? 2 : seg;
                transpose_item(w_in + (size_t)l * D * D_IN, D_IN, 64 * kb, sseg * 512 + (db & 15) * 32, WIN + (size_t)l * NPROJ * D, D, 32 * db, scr, lane); }
            else { r -= I_IN; const int kb = r / (D / 32), db = r % (D / 32);
                transpose_item(w_out + (size_t)l * D * D, D, 64 * kb, 32 * db, WOUT + (size_t)l * D * D, D, 32 * db, scr, lane); }
        }
        for (int i = bx * (NWAVES * 64) + tid; i < DEPTH * D * 2; i += G * NWAVES * 64) { const int l = i / (2 * D), col = (i >> 1) % D, hf = i & 1, ln = (col & 255) >> 2, c = col & 3, j = col >> 8;
            *(f32x4*)(WFP + (size_t)l * 2 * D * 4 + (size_t)(((j * 4 + c) * 2 + hf) * 64 + ln) * 4) = *(const f32x4*)(w_in + ((size_t)l * D + col) * D_IN + NPROJ + 4 * hf); }
        if (bx < DEPTH * 48) {
            const int l = bx / 48, cb = bx % 48, cl = tid & 15, kg = tid >> 4;
            const float* wp = w_ada + ((size_t)l * D + kg) * (3 * D) + cb * 64 + 4 * cl;
            f32x4 a0 = (f32x4){0.f, 0.f, 0.f, 0.f}, a1 = a0;
#pragma unroll 8
            for (int i = 0; i < 32; ++i) { const f32x4 w = *(const f32x4*)(wp + (size_t)(32 * i) * (3 * D)); const float c0 = silu_f(c_in[kg + 32 * i]), c1 = silu_f(c_in[D + kg + 32 * i]); a0 += w * c0; a1 += w * c1; }
            LAS f32x4* red = (LAS f32x4*)L;
            __syncthreads();
            red[(kg * 2 + 0) * 16 + cl] = a0; red[(kg * 2 + 1) * 16 + cl] = a1;
            __syncthreads();
            if (tid < 32) { const int b = tid >> 4, c2 = tid & 15; f32x4 s = *(const f32x4*)(b_ada + (size_t)l * 3 * D + cb * 64 + 4 * c2);
                for (int k2 = 0; k2 < 32; ++k2) s += red[(k2 * 2 + b) * 16 + c2];
                *(f32x4*)(ADA + ((size_t)l * 2 + b) * 3 * D + cb * 64 + 4 * c2) = s; }
            __syncthreads();
        }
    }
    SEAM(0);

    for (int l = 0; l < DEPTH; ++l) {
        const int pb = 1 + 4 * l;
        const float* xsrc = (l == 0) ? x_in : out;
        const float* ada = ADA + (size_t)l * 2 * 3 * D;
        if (IN(pb)) { PHASE_IDS();
            const float* wf = WFP + (size_t)l * 2 * D * 4 + 4 * lane;
            f32x4 wfa[4][4][2], gv[4];
#pragma unroll
            for (int j = 0; j < 4; ++j) { gv[j] = *(const f32x4*)(g_norm + l * D + 4 * lane + 256 * j);
#pragma unroll
                for (int c = 0; c < 4; ++c) { wfa[j][c][0] = *(const f32x4*)(wf + ((j * 4 + c) * 2 + 0) * 256); wfa[j][c][1] = *(const f32x4*)(wf + ((j * 4 + c) * 2 + 1) * 256); } }
            const float bfl = (lane < 8) ? b_f[l * 8 + lane] : 0.f;
            f32x4 v[4];
#pragma unroll
            for (int j = 0; j < 4; ++j) v[j] = *(const f32x4*)(xsrc + (size_t)gw * D + 4 * lane + 256 * j);
            for (int m = gw; m < M; m += NGW) {
                const float* ab = ada + (size_t)(m / T) * 3 * D;
                f32x4 vn[4]; const int mn = (m + NGW < M) ? m + NGW : m;
#pragma unroll
                for (int j = 0; j < 4; ++j) vn[j] = *(const f32x4*)(xsrc + (size_t)mn * D + 4 * lane + 256 * j);
                float ss = 0.f;
#pragma unroll
                for (int j = 0; j < 4; ++j) ss += (v[j].x * v[j].x + v[j].y * v[j].y) + (v[j].z * v[j].z + v[j].w * v[j].w);
                const float rstd = 1.0f / sqrtf(wave_sum(ss) * (1.f / D) + EPS);
                float f[8];
#pragma unroll
                for (int k = 0; k < 8; ++k) f[k] = 0.f;
#pragma unroll
                for (int j = 0; j < 4; ++j) { const f32x4 sh = *(const f32x4*)(ab + 4 * lane + 256 * j), sc = *(const f32x4*)(ab + D + 4 * lane + 256 * j);
                    const f32x4 hh = (v[j] * rstd) * gv[j] * (sc + 1.0f) + sh;
                    *(unsigned long long*)(XN + (size_t)m * D + 4 * lane + 256 * j) = (unsigned long long)pk2(hh.x, hh.y) | ((unsigned long long)pk2(hh.z, hh.w) << 32);
#pragma unroll
                    for (int c = 0; c < 4; ++c) {
#pragma unroll
                        for (int k = 0; k < 4; ++k) { f[k] += hh[c] * wfa[j][c][0][k]; f[4 + k] += hh[c] * wfa[j][c][1][k]; } } }
#pragma unroll
                for (int k = 0; k < 8; ++k) f[k] = wave_sum(f[k]);
                float fv = f[0];
#pragma unroll
                for (int k = 1; k < 8; ++k) fv = (lane == k) ? f[k] : fv;
                if (lane < 8) { const float tt = -(fv + bfl) * LOG2E;
                    const float lf = (tt > 30.f) ? -tt : -__builtin_amdgcn_logf(1.0f + __builtin_amdgcn_exp2f(tt));
                    LOGF[(size_t)m * 8 + lane] = lf; }
#pragma unroll
                for (int j = 0; j < 4; ++j) v[j] = vn[j];
            }
        }
        SEAM(pb);
        if (IN(pb + 1)) {
            if (bx < BATCH * 8) { PHASE_IDS();
                const int b = bx >> 3, h8 = bx & 7; LAS float* wt = (LAS float*)(L + MISC_OFF);
                float pv[16]; float run = 0.f;
#pragma unroll
                for (int i = 0; i < 16; ++i) { run += LOGF[((size_t)b * T + 16 * tid + i) * 8 + h8]; pv[i] = run; }
                float inc = run;
#pragma unroll
                for (int o = 1; o < 64; o <<= 1) { const float t = __shfl_up(inc, o); if (lane >= o) inc += t; }
                if (lane == 63) wt[wave] = inc;
                __syncthreads();
                float off = inc - run;
                for (int w = 0; w < wave; ++w) off += wt[w];
#pragma unroll
                for (int i = 0; i < 16; ++i) CUM[(size_t)bx * T + 16 * tid + i] = off + pv[i];
                __syncthreads();
            }
            pg8::Gemm g{XN, WIN + (size_t)l * NPROJ * D, M, NPROJ, D}; pg8::StaticOrder S; S.init(M, NPROJ, G, bx);
            pg8::EpiBf16<0> E{VT, 2, 512, KN + (size_t)l * 16 * 128 * 2, 1, 512, T, QO, D, nullptr, D, (size_t)(WS_K - WS_QO) / 2, attn_body::C2};
            pg8::gemm_phase<pg8::EpiBf16<0>, pg8::StaticOrder, PG8_ALIGN, PG8_SP2>(L, g, S, E);
        }
        SEAM(pb + 1);
        if (IN(pb + 2)) {
            const attn_body::bf16* Qp = (const attn_body::bf16*)QO; const attn_body::bf16* Kp = (const attn_body::bf16*)KB; const attn_body::bf16* Vp = (const attn_body::bf16*)VB;
            const float* ggl = g_grp + (size_t)l * D;
            volatile LAS unsigned* const qw = (volatile LAS unsigned*)(L + MISC_OFF + 32);
            const int xq0 = bx & 7; bool own = true;
            for (;;) {
                __syncthreads();
                if (threadIdx.x < 64) { const int ln = threadIdx.x; unsigned idx = 0xffffffffu; int qsel = xq0;
                    if (own) { unsigned r = 0u; if (ln == 0) r = atomicAdd(QCTR + (size_t)(l * 8 + xq0) * 64, 1u); r = (unsigned)__builtin_amdgcn_readfirstlane((int)r); if (r < 128u) idx = r; else own = false; }
                    if (!own && idx == 0xffffffffu) {
                        for (;;) {
                            const unsigned c = (ln < 8) ? __hip_atomic_load(QCTR + (size_t)(l * 8 + ln) * 64, __ATOMIC_RELAXED, __HIP_MEMORY_SCOPE_AGENT) : 128u;
                            const unsigned a8 = (unsigned)__ballot(c < 128u) & 0xffu;
                            if (!a8) break;
                            const unsigned rot = ((a8 >> xq0) | (a8 << (8 - xq0))) & 0xffu; const int q = (xq0 + __builtin_ctz(rot)) & 7;
                            unsigned r = 0u; if (ln == 0) r = atomicAdd(QCTR + (size_t)(l * 8 + q) * 64, 1u); r = (unsigned)__builtin_amdgcn_readfirstlane((int)r);
                            if (r < 128u) { idx = r; qsel = q; break; }
                        } }
                    if (ln == 0) { qw[0] = idx; qw[1] = (unsigned)qsel; } }
                __syncthreads();
                const unsigned idx = qw[0]; const int xq = (int)qw[1], qb_ = xq >> 2, pr = xq & 3;
                if (idx >= 128u) break;
                if (idx < 64u) { const int h8 = (idx & 1u) ? pr : 7 - pr, qb = 31 - (int)(idx >> 1), bh = qb_ * 8 + h8;
                    attn_body::attn_unit<8>(qb_, 8 + h8, qb, Qp, Kp, Vp, (attn_body::bf16*)OB, CUM + (size_t)bh * T, KN + ((size_t)l * 16 + bh) * 256, (const attn_body::bf16*)GB, ggl, SSQ, (char*)lds); }
                else { const unsigned j2 = idx - 64u; attn_body::sb_unit(qb_, 2 * pr + (int)(j2 & 1u), 31 - (int)(j2 >> 1), Qp, Kp, (const attn_body::bf16*)VT, (attn_body::bf16*)OB, (const attn_body::bf16*)GB, ggl, SSQ); }
            }
        }
        SEAM(pb + 2);
        if (IN(pb + 3)) {
            pg8::Gemm g{OB, WOUT + (size_t)l * D * D, M, D, D}; pg8::StaticOrder S; S.init(M, D, G, bx);
            pg8::EpiRes E{xsrc, out, D, ada + 2 * D, T, 3 * D, SSQ, EPS};
            pg8::gemm_phase<pg8::EpiRes, pg8::StaticOrder, PG8_ALIGN, PG8_SP2>(L, g, S, E);
        }
        SEAM(pb + 3);
    }
    if (IN(N_PHASES - 1)) { PHASE_IDS();
        f32x4 gv[4];
#pragma unroll
        for (int j = 0; j < 4; ++j) gv[j] = *(const f32x4*)(g_final + 4 * lane + 256 * j);
        for (int m = gw; m < M; m += NGW) {
            f32x4 v[4]; float ss = 0.f;
#pragma unroll
            for (int j = 0; j < 4; ++j) { v[j] = *(const f32x4*)(out + (size_t)m * D + 4 * lane + 256 * j); ss += (v[j].x * v[j].x + v[j].y * v[j].y) + (v[j].z * v[j].z + v[j].w * v[j].w); }
            const float rstd = 1.0f / sqrtf(wave_sum(ss) * (1.f / D) + EPS);
#pragma unroll
            for (int j = 0; j < 4; ++j) *(f32x4*)(out + (size_t)m * D + 4 * lane + 256 * j) = (v[j] * rstd) * gv[j];
        }
    }
#undef IN
#undef SEAM
}

extern "C" void kernel_launch(void* const* d_in, const int* in_sizes, int n_in, void* d_out, int out_size, void* d_ws, size_t ws_size, hipStream_t stream) {
    static int grid = 0;
    if (grid == 0) {
        if (n_in != 10 || in_sizes[0] != M * D || out_size != M * D || ws_size < WS_END) { fprintf(stderr, "kernel_launch: unexpected shapes (n_in %d, in0 %d, out %d, ws %zu)\n", n_in, n_in > 0 ? in_sizes[0] : -1, out_size, ws_size); grid = -1; return; }
        int dev = 0, cus = 0, per_cu = 0;
        if (hipGetDevice(&dev) != hipSuccess || hipDeviceGetAttribute(&cus, hipDeviceAttributeMultiprocessorCount, dev) != hipSuccess) { grid = -1; return; }
        if (hipFuncSetAttribute((const void*)hyb_fwd, hipFuncAttributeMaxDynamicSharedMemorySize, LDS_BYTES) != hipSuccess) { fprintf(stderr, "kernel_launch: hipFuncSetAttribute failed\n"); grid = -1; return; }
        if (hipOccupancyMaxActiveBlocksPerMultiprocessor(&per_cu, (const void*)hyb_fwd, NWAVES * 64, LDS_BYTES) != hipSuccess || per_cu < 1) { fprintf(stderr, "kernel_launch: occupancy query says %d\n", per_cu); per_cu = 1; }
        (void)hipGetLastError();
        grid = cus * 1;
    }
    if (grid < 0) return;
    if (hipMemsetAsync((char*)d_ws + WS_CTL, 0, CTL_ZERO_BYTES, stream) != hipSuccess) { fprintf(stderr, "kernel_launch: memset failed\n"); return; }
    Args a{};
    for (int i = 0; i < 10; ++i) a.in[i] = (const float*)d_in[i];
    a.out = (float*)d_out; a.ws = (unsigned char*)d_ws;
#if MK_PER_PHASE
    for (int p = 0; p < N_PHASES; ++p) { a.ph_lo = p; a.ph_hi = p + 1; void* kargs[] = {&a};
        hipError_t e = hipLaunchCooperativeKernel((const void*)hyb_fwd, dim3(grid), dim3(NWAVES * 64), kargs, LDS_BYTES, stream);
        if (e != hipSuccess) { fprintf(stderr, "kernel_launch: launch of phase %d failed: %s\n", p, hipGetErrorString(e)); break; } }
#else
    a.ph_lo = 0; a.ph_hi = N_PHASES; void* kargs[] = {&a};
    hipError_t e = hipLaunchCooperativeKernel((const void*)hyb_fwd, dim3(grid), dim3(NWAVES * 64), kargs, LDS_BYTES, stream);
    if (e != hipSuccess) fprintf(stderr, "kernel_launch: cooperative launch failed: %s (grid %d)\n", hipGetErrorString(e), grid);
#endif
}
```
